# Optimizing an MI355X kernel written in HIP

```python
import jax, jax.numpy as jnp
from jax import lax
import numpy as np

D_MODEL = 1024
BATCH = 16
SEQ = 2048
DEPTH = 2

GRID_W = 64
CTX_LEN = 256
ROPE_THETA = 10000.0
NORM_EPS = 1e-6
NEG = -1e30

BRANCH_WIDTH = D_MODEL // 2
N_BRANCH = 3

A_HEAD = 64
A_HEADS = BRANCH_WIDTH // A_HEAD
A_DECAY_LORA = 64
A_ICLR_LORA = 64
A_GN_EPS = 64e-5
A_SHIFT_COLS = 3 * BRANCH_WIDTH + 2 * A_DECAY_LORA + 2 * A_ICLR_LORA

B_HEADS = 8
B_NOPE = 64
B_ROPE = 32
B_QK = B_NOPE + B_ROPE
B_V = BRANCH_WIDTH // B_HEADS
B_Q_LORA = 256
B_KV_LORA = 128
B_PROJ_COLS = B_Q_LORA + B_KV_LORA + B_ROPE
Q_BLOCK = 128

C_HEAD = 64
C_HEADS = BRANCH_WIDTH // C_HEAD
C_KV_HEADS = 2
C_GROUP = C_HEADS // C_KV_HEADS
C_KV_WIDTH = C_KV_HEADS * C_HEAD
C_PROJ_COLS = BRANCH_WIDTH + 2 * C_KV_WIDTH
WINDOW = 128
W_BLOCK = 128

IN_CUTS = (
    A_SHIFT_COLS,
    A_SHIFT_COLS + BRANCH_WIDTH,
    A_SHIFT_COLS + BRANCH_WIDTH + B_PROJ_COLS,
    A_SHIFT_COLS + 2 * BRANCH_WIDTH + B_PROJ_COLS,
    A_SHIFT_COLS + 2 * BRANCH_WIDTH + B_PROJ_COLS + C_PROJ_COLS,
    A_SHIFT_COLS + 3 * BRANCH_WIDTH + B_PROJ_COLS + C_PROJ_COLS,
)
N_IN = IN_CUTS[-1] + N_BRANCH * D_MODEL

kernel_name = "hybrid_rwkv7_mla_swa_diffusion_block"


def rms_norm(x, gain, eps=NORM_EPS):
    xf = x.astype(jnp.float32)
    y = xf * lax.rsqrt(jnp.mean(xf * xf, axis=-1, keepdims=True) + eps)
    return (y * gain.astype(jnp.float32)).astype(x.dtype)


def axial_rope_tables(n_tokens, rot_dim):
    rows = n_tokens // GRID_W
    row = jnp.repeat(jnp.arange(rows), GRID_W).astype(jnp.float32)
    col = jnp.tile(jnp.arange(GRID_W), rows).astype(jnp.float32)
    axis_dim = rot_dim // 2
    inv = ROPE_THETA ** (-(2.0 * jnp.arange(axis_dim // 2, dtype=jnp.float32)) / axis_dim)
    ang = jnp.concatenate([row[:, None] * inv, col[:, None] * inv], axis=-1)
    return jnp.cos(ang), jnp.sin(ang)


def apply_axial_rope(x, cos, sin):
    a = x.shape[-1] // 2
    q = a // 2
    c = cos[:, None, :].astype(x.dtype)
    s = sin[:, None, :].astype(x.dtype)

    def rot(xa, ca, sa):
        x1, x2 = xa[..., :q], xa[..., q:]
        return jnp.concatenate([x1 * ca - x2 * sa, x1 * sa + x2 * ca], axis=-1)

    return jnp.concatenate([rot(x[..., :a], c[..., :q], s[..., :q]),
                            rot(x[..., a:], c[..., q:], s[..., q:])], axis=-1)


def token_shift(z, mu_prev, mu_next):
    prev = jnp.pad(z[:, :-1], ((0, 0), (1, 0), (0, 0)))
    nxt = jnp.pad(z[:, 1:], ((0, 0), (0, 1), (0, 0)))
    return z + mu_prev * (prev - z) + mu_next * (nxt - z)


def rwkv7_prepare(z, mu_prev, mu_next, w0, w_up, a0, a_up, k_k, k_a):
    B, T, _ = z.shape
    z = token_shift(z, mu_prev, mu_next).astype(jnp.float32)
    r, k, v, wd, ad = jnp.split(
        z, [BRANCH_WIDTH, 2 * BRANCH_WIDTH, 3 * BRANCH_WIDTH, 3 * BRANCH_WIDTH + 2 * A_DECAY_LORA], axis=-1)
    wd = wd.reshape(B, T, 2, A_DECAY_LORA)
    ad = ad.reshape(B, T, 2, A_ICLR_LORA)
    w_log = -jax.nn.softplus(-(w0 + jnp.einsum('btdr,drc->btdc', jnp.tanh(wd), w_up))) - 0.5
    decay = jnp.exp(-jnp.exp(w_log))
    a = jax.nn.sigmoid(a0 + jnp.einsum('btdr,drc->btdc', ad, a_up))
    kk = (k * k_k).reshape(B, T, A_HEADS, A_HEAD)
    kk = kk * lax.rsqrt(jnp.maximum(jnp.sum(kk * kk, axis=-1, keepdims=True), 1e-24))
    k_dir = k[:, :, None, :] * (1.0 + (a - 1.0) * k_a)
    heads = lambda t: t.reshape(B, T, 2, A_HEADS, A_HEAD)
    return (r.reshape(B, T, A_HEADS, A_HEAD), v.reshape(B, T, A_HEADS, A_HEAD), kk,
            heads(decay), heads(k_dir), heads(a))


def rwkv7_scan(r, decay, k, v, kk, a, s0, reverse):
    def step(S, inp):
        r_t, w_t, k_t, v_t, kk_t, a_t = inp
        sa = jnp.einsum('bhvk,bhk->bhv', S, kk_t)
        S = (S * w_t[:, :, None, :] - sa[..., None] * (kk_t * a_t)[:, :, None, :]
             + v_t[..., None] * k_t[:, :, None, :])
        return S, jnp.einsum('bhvk,bhk->bhv', S, r_t)

    xs = tuple(jnp.swapaxes(t, 0, 1) for t in (r, decay, k, v, kk, a))
    s_final, ys = lax.scan(step, s0, xs, reverse=reverse)
    return s_final, jnp.swapaxes(ys, 0, 1)


def rwkv7_readout(y, r, v, k_dir, r_k, gn_g, gn_b, dtype):
    B, T = y.shape[:2]
    mu = jnp.mean(y, axis=-1, keepdims=True)
    var = jnp.mean(jnp.square(y - mu), axis=-1, keepdims=True)
    yn = ((y - mu) * lax.rsqrt(var + A_GN_EPS)).reshape(B, T, BRANCH_WIDTH) * gn_g + gn_b
    bonus = jnp.sum(r[:, :, None] * k_dir * r_k, axis=-1, keepdims=True) * v[:, :, None]
    return (yn + jnp.sum(bonus, axis=2).reshape(B, T, BRANCH_WIDTH)).astype(dtype)


def rwkv7_branch(za, zac, mu_prev, mu_next, w0, w_up, a0, a_up, k_k, k_a, r_k, gn_g, gn_b, ctx_out):
    lat = rwkv7_prepare(za, mu_prev, mu_next, w0, w_up, a0, a_up, k_k, k_a)
    cx = rwkv7_prepare(zac, mu_prev, mu_next, w0, w_up, a0, a_up, k_k, k_a)
    B = za.shape[0]
    s0 = jnp.zeros((B, A_HEADS, A_HEAD, A_HEAD), jnp.float32)
    y_lat = jnp.zeros(lat[0].shape, jnp.float32)
    y_ctx = jnp.zeros(cx[0].shape, jnp.float32)
    for d, rev in ((0, False), (1, True)):
        sel = lambda p: (p[0], p[3][:, :, d], p[4][:, :, d], p[1], p[2], p[5][:, :, d])
        s_ctx, yc = rwkv7_scan(*sel(cx), s0, rev)
        _, yl = rwkv7_scan(*sel(lat), s_ctx, rev)
        y_lat = y_lat + yl
        y_ctx = y_ctx + yc
    out_lat = rwkv7_readout(y_lat, lat[0], lat[1], lat[4], r_k, gn_g, gn_b, za.dtype)
    out_ctx = rwkv7_readout(y_ctx, cx[0], cx[1], cx[4], r_k, gn_g, gn_b, za.dtype) if ctx_out else None
    return out_lat, out_ctx


def mla_project(zb, q_ln, kv_ln, w_uq, w_ukv, qn_g, kn_g, rope):
    B, T, _ = zb.shape
    cq, ckv, kr = jnp.split(zb, [B_Q_LORA, B_Q_LORA + B_KV_LORA], axis=-1)
    q = (rms_norm(cq, q_ln) @ w_uq).reshape(B, T, B_HEADS, B_QK)
    kv = (rms_norm(ckv, kv_ln) @ w_ukv).reshape(B, T, B_HEADS, B_NOPE + B_V)
    k_nope, v = kv[..., :B_NOPE], kv[..., B_NOPE:]
    k = jnp.concatenate([k_nope, jnp.broadcast_to(kr[:, :, None, :], (B, T, B_HEADS, B_ROPE))], axis=-1)
    q = rms_norm(q, qn_g)
    k = rms_norm(k, kn_g)
    if rope is not None:
        cos, sin = rope
        q = jnp.concatenate([q[..., :B_NOPE], apply_axial_rope(q[..., B_NOPE:], cos, sin)], axis=-1)
        k = jnp.concatenate([k[..., :B_NOPE], apply_axial_rope(k[..., B_NOPE:], cos, sin)], axis=-1)
    return q, k, v


def dense_block_attention(q, k, v):
    B, T, H, Dq = q.shape
    nb = T // Q_BLOCK
    qb = jnp.swapaxes(q.reshape(B, nb, Q_BLOCK, H, Dq), 0, 1)

    def one(qx):
        s = jnp.einsum('bqhd,bkhd->bhqk', qx, k, preferred_element_type=jnp.float32) * (Dq ** -0.5)
        p = jax.nn.softmax(s, axis=-1).astype(v.dtype)
        return jnp.einsum('bhqk,bkhd->bqhd', p, v)

    o = lax.map(one, qb)
    return jnp.swapaxes(o, 0, 1).reshape(B, T, H * v.shape[-1])


def gqa_project(zc, qn_g, kn_g, rope):
    B, T, _ = zc.shape
    q, k, v = jnp.split(zc, [BRANCH_WIDTH, BRANCH_WIDTH + C_KV_WIDTH], axis=-1)
    q = rms_norm(q.reshape(B, T, C_HEADS, C_HEAD), qn_g)
    k = rms_norm(k.reshape(B, T, C_KV_HEADS, C_HEAD), kn_g)
    v = v.reshape(B, T, C_KV_HEADS, C_HEAD)
    if rope is not None:
        q = apply_axial_rope(q, *rope)
        k = apply_axial_rope(k, *rope)
    return q, k, v


def sink_gqa(q, k, v, sink, valid):
    B, Q, H, D = q.shape
    qg = q.reshape(B, Q, C_KV_HEADS, C_GROUP, D)
    s = jnp.einsum('bqkgd,bskd->bkgqs', qg, k, preferred_element_type=jnp.float32) * (D ** -0.5)
    s = jnp.where(valid, s, NEG)
    sk = jnp.broadcast_to(sink.astype(jnp.float32).reshape(C_KV_HEADS, C_GROUP, 1, 1), s.shape[:-1] + (1,))
    p = jax.nn.softmax(jnp.concatenate([s, sk], axis=-1), axis=-1)[..., :-1].astype(v.dtype)
    return jnp.einsum('bkgqs,bskd->bqkgd', p, v).reshape(B, Q, H * D)


def window_attention(q, k, v, kc, vc, sink):
    B, T, H, D = q.shape
    L = kc.shape[1]
    nb = T // W_BLOCK

    def band(t):
        tp = jnp.pad(t, ((0, 0), (W_BLOCK, W_BLOCK), (0, 0), (0, 0)))
        views = [tp[:, j * W_BLOCK: j * W_BLOCK + T].reshape(B, nb, W_BLOCK, C_KV_HEADS, D) for j in range(3)]
        return jnp.swapaxes(jnp.concatenate(views, axis=2), 0, 1)

    kb, vb = band(k), band(v)
    qb = jnp.swapaxes(q.reshape(B, nb, W_BLOCK, H, D), 0, 1)
    qi = jnp.arange(W_BLOCK)[:, None]
    kj = jnp.arange(3 * W_BLOCK)[None, :]
    kpos = jnp.arange(nb)[:, None, None] * W_BLOCK + kj - W_BLOCK
    valid = (jnp.abs(kj - W_BLOCK - qi) <= WINDOW)[None] & (kpos >= 0) & (kpos < T)
    valid = jnp.concatenate([valid, jnp.ones((nb, W_BLOCK, L), bool)], axis=-1)

    def one(args):
        qx, kx, vx, m = args
        return sink_gqa(qx, jnp.concatenate([kx, kc], axis=1), jnp.concatenate([vx, vc], axis=1), sink, m)

    o = lax.map(one, (qb, kb, vb, valid))
    return jnp.swapaxes(o, 0, 1).reshape(B, T, H * D)


def merge_branches(ys, gs, zg, w_branch_out, w_out):
    gates = jax.nn.sigmoid(zg).reshape(zg.shape[:-1] + (N_BRANCH, D_MODEL))
    m = gates[..., 0, :] * ((ys[0] * jax.nn.silu(gs[0])) @ w_branch_out[0])
    for n in range(1, N_BRANCH):
        m = m + gates[..., n, :] * ((ys[n] * jax.nn.silu(gs[n])) @ w_branch_out[n])
    return m @ w_out


def trunk_layer(x, xc, c, c_ctx, ada_w, ada_b, norm_g, w_in,
                a_mu_prev, a_mu_next, a_w0, a_w_up, a_a0, a_a_up, a_k_k, a_k_a, a_r_k, a_gn_g, a_gn_b,
                b_q_ln, b_kv_ln, b_w_uq, b_w_ukv, b_qn_g, b_kn_g,
                c_qn_g, c_kn_g, c_sink, w_branch_out, w_out, rope_b, rope_c, ctx_out):
    mod = jax.nn.silu(c) @ ada_w + ada_b
    mod_c = jax.nn.silu(c_ctx) @ ada_w + ada_b
    shift, scale, gate = jnp.split(mod[:, None, :], 3, axis=-1)
    shift_c, scale_c, gate_c = jnp.split(mod_c, 3, axis=-1)
    h = rms_norm(x, norm_g) * (1.0 + scale) + shift
    hc = rms_norm(xc, norm_g) * (1.0 + scale_c) + shift_c

    za, ga, zb, gb, zc, gc, zg = jnp.split(h @ w_in, list(IN_CUTS), axis=-1)
    zac, gac, zbc, gbc, zcc, gcc, zgc = jnp.split(hc @ w_in, list(IN_CUTS), axis=-1)

    ya, yac = rwkv7_branch(za, zac, a_mu_prev, a_mu_next, a_w0, a_w_up, a_a0, a_a_up,
                           a_k_k, a_k_a, a_r_k, a_gn_g, a_gn_b, ctx_out)

    qb_, kb_, vb_ = mla_project(zb, b_q_ln, b_kv_ln, b_w_uq, b_w_ukv, b_qn_g, b_kn_g, rope_b)
    qbc, kbc, vbc = mla_project(zbc, b_q_ln, b_kv_ln, b_w_uq, b_w_ukv, b_qn_g, b_kn_g, None)
    yb = dense_block_attention(qb_, jnp.concatenate([kbc, kb_], axis=1), jnp.concatenate([vbc, vb_], axis=1))

    qc_, kc_, vc_ = gqa_project(zc, c_qn_g, c_kn_g, rope_c)
    qcc, kcc, vcc = gqa_project(zcc, c_qn_g, c_kn_g, None)
    yc = window_attention(qc_, kc_, vc_, kcc, vcc, c_sink)

    x_new = x + gate * merge_branches((ya, yb, yc), (ga, gb, gc), zg, w_branch_out, w_out)
    if ctx_out:
        ybc = dense_block_attention(qbc, kbc, vbc)
        L = xc.shape[1]
        ycc = sink_gqa(qcc, kcc, vcc, c_sink, jnp.ones((L, L), bool))
        xc_new = xc + gate_c * merge_branches((yac, ybc, ycc), (gac, gbc, gcc), zgc, w_branch_out, w_out)
    else:
        xc_new = xc
    return x_new, xc_new


def setup_inputs(seed: int = 0) -> dict:
    key = jax.random.key(seed)
    ks = iter(jax.random.split(key, 48))
    nrm = lambda shape, s: jax.random.normal(next(ks), shape, jnp.float32) * s
    uni = lambda shape, lo, hi: jax.random.uniform(next(ks), shape, jnp.float32, lo, hi)
    L = DEPTH
    return {
        "x": nrm((BATCH, SEQ, D_MODEL), 1.0),
        "c": nrm((BATCH, D_MODEL), 1.0),
        "ctx": nrm((BATCH, CTX_LEN, D_MODEL), 1.0),
        "c_ctx": nrm((D_MODEL,), 1.0),
        "ada_w": nrm((L, D_MODEL, 3 * D_MODEL), 0.5 * D_MODEL ** -0.5),
        "ada_b": nrm((L, 3 * D_MODEL), 0.02),
        "norm_g": 1.0 + nrm((L, D_MODEL), 0.02),
        "w_in": nrm((L, D_MODEL, N_IN), D_MODEL ** -0.5),
        "a_mu_prev": uni((L, A_SHIFT_COLS), 0.0, 0.5),
        "a_mu_next": uni((L, A_SHIFT_COLS), 0.0, 0.5),
        "a_w0": uni((L, 2, BRANCH_WIDTH), -6.0, 1.0),
        "a_w_up": nrm((L, 2, A_DECAY_LORA, BRANCH_WIDTH), 0.1),
        "a_a0": nrm((L, 2, BRANCH_WIDTH), 0.5),
        "a_a_up": nrm((L, 2, A_ICLR_LORA, BRANCH_WIDTH), 0.1),
        "a_k_k": 0.85 + nrm((L, BRANCH_WIDTH), 0.02),
        "a_k_a": 1.0 + nrm((L, BRANCH_WIDTH), 0.02),
        "a_r_k": nrm((L, A_HEADS, A_HEAD), 0.1),
        "a_gn_g": 1.0 + nrm((L, BRANCH_WIDTH), 0.02),
        "a_gn_b": nrm((L, BRANCH_WIDTH), 0.02),
        "b_q_ln": 1.0 + nrm((L, B_Q_LORA), 0.02),
        "b_kv_ln": 1.0 + nrm((L, B_KV_LORA), 0.02),
        "b_w_uq": nrm((L, B_Q_LORA, B_HEADS * B_QK), B_Q_LORA ** -0.5),
        "b_w_ukv": nrm((L, B_KV_LORA, B_HEADS * (B_NOPE + B_V)), B_KV_LORA ** -0.5),
        "b_qn_g": 1.0 + nrm((L, B_QK), 0.02),
        "b_kn_g": 1.0 + nrm((L, B_QK), 0.02),
        "c_qn_g": 1.0 + nrm((L, C_HEAD), 0.02),
        "c_kn_g": 1.0 + nrm((L, C_HEAD), 0.02),
        "c_sink": nrm((L, C_HEADS), 0.5),
        "w_branch_out": nrm((L, N_BRANCH, BRANCH_WIDTH, D_MODEL), BRANCH_WIDTH ** -0.5),
        "w_out": nrm((L, D_MODEL, D_MODEL), D_MODEL ** -0.5),
    }


def reference(x, c, ctx, c_ctx, ada_w, ada_b, norm_g, w_in,
              a_mu_prev, a_mu_next, a_w0, a_w_up, a_a0, a_a_up, a_k_k, a_k_a, a_r_k, a_gn_g, a_gn_b,
              b_q_ln, b_kv_ln, b_w_uq, b_w_ukv, b_qn_g, b_kn_g,
              c_qn_g, c_kn_g, c_sink, w_branch_out, w_out):
    n_tok = x.shape[1]
    rope_b = axial_rope_tables(n_tok, B_ROPE)
    rope_c = axial_rope_tables(n_tok, C_HEAD)
    xc = ctx
    for i in range(DEPTH):
        x, xc = trunk_layer(
            x, xc, c, c_ctx, ada_w[i], ada_b[i], norm_g[i], w_in[i],
            a_mu_prev[i], a_mu_next[i], a_w0[i], a_w_up[i], a_a0[i], a_a_up[i],
            a_k_k[i], a_k_a[i], a_r_k[i], a_gn_g[i], a_gn_b[i],
            b_q_ln[i], b_kv_ln[i], b_w_uq[i], b_w_ukv[i], b_qn_g[i], b_kn_g[i],
            c_qn_g[i], c_kn_g[i], c_sink[i], w_branch_out[i], w_out[i],
            rope_b, rope_c, i < DEPTH - 1)
    return x
```

```cpp
#include <hip/hip_runtime.h>
#include <hip/hip_cooperative_groups.h>
#include <stdint.h>
#include <stdio.h>
#include <string.h>
namespace cg = cooperative_groups;

typedef unsigned short bf16;
using bf16x8 = __attribute__((ext_vector_type(8))) short;
using f32x16 = __attribute__((ext_vector_type(16))) float;
typedef float float2v __attribute__((ext_vector_type(2)));
typedef uint32_t u32x4 __attribute__((ext_vector_type(4)));
typedef unsigned int u32x2v __attribute__((ext_vector_type(2)));
typedef float f32x4v __attribute__((ext_vector_type(4)));

#define DEV __device__ __forceinline__

constexpr int NROWS = 36864;
constexpr int TPB = 2304;
constexpr int NIN = 7584;

struct Params {
  const float *x, *c, *ctx, *c_ctx, *ada_w, *ada_b, *norm_g, *w_in, *a_mu_prev, *a_mu_next, *a_w0, *a_w_up,
      *a_a0, *a_a_up, *a_k_k, *a_k_a, *a_r_k, *a_gn_g, *a_gn_b, *b_q_ln, *b_kv_ln, *b_w_uq, *b_w_ukv, *b_qn_g,
      *b_kn_g, *c_qn_g, *c_kn_g, *c_sink, *w_branch_out, *w_out;
  float* out;
  bf16 *WT1, *WT2, *WT3, *WUQ, *WUKV, *WBO, *WOUT;
  float *MOD, *XC, *SB, *ROPE;
  bf16 *HY, *ZA, *ZB, *ZC, *Q, *KV, *KR;
  unsigned int* counters;
  unsigned long long pad_;
};

typedef const Params __attribute__((address_space(4))) CParams;
typedef CParams& PRef;

typedef __bf16 hbf16x2 __attribute__((ext_vector_type(2)));
DEV bf16 f2bf(float f) {
  __bf16 h = (__bf16)f;
  return __builtin_bit_cast(bf16, h);
}
DEV uint32_t pack2(float a, float b) {
  hbf16x2 v = __builtin_convertvector(float2v{a, b}, hbf16x2);
  return __builtin_bit_cast(uint32_t, v);
}
DEV float bf2f(bf16 h) { return __uint_as_float(((uint32_t)h) << 16); }
template <int CTRL>
DEV float dpp_mov(float v) {
  return __int_as_float(__builtin_amdgcn_update_dpp(0, __float_as_int(v), CTRL, 0xf, 0xf, true));
}
DEV float wave_sum(float v) {
  v += dpp_mov<0xB1>(v);
  v += dpp_mov<0x4E>(v);
  v += dpp_mov<0x141>(v);
  v += dpp_mov<0x140>(v);
  int vi = __float_as_int(v);
  float r0 = __int_as_float(__builtin_amdgcn_readlane(vi, 0));
  float r1 = __int_as_float(__builtin_amdgcn_readlane(vi, 16));
  float r2 = __int_as_float(__builtin_amdgcn_readlane(vi, 32));
  float r3 = __int_as_float(__builtin_amdgcn_readlane(vi, 48));
  return (r0 + r1) + (r2 + r3);
}
DEV void wbar() { __builtin_amdgcn_wave_barrier(); }
DEV void lds_barrier() { asm volatile("s_waitcnt lgkmcnt(0)\n\ts_barrier" ::: "memory"); }
DEV const float* xrow_ptr(const float* xl, const float* xc, int R) {
  int b = R / TPB, tp = R % TPB;
  return tp < 256 ? xc + ((size_t)b * 256 + tp) * 1024 : xl + ((size_t)b * 2048 + (tp - 256)) * 1024;
}

DEV int tid_() { int t = threadIdx.x; asm volatile("" : "+v"(t)); return t; }
DEV int bid_() { int b = blockIdx.x; asm volatile("" : "+s"(b)); return b; }

__device__ void phase_mod(PRef p, float* smem) {
  float* sc = smem;
  float* red = smem + 17 * 256;
  int tid = tid_();
  int kg = tid >> 5, col = tid & 31;
  for (int e = bid_() * 256 + tid; e < 2048 * 48; e += gridDim.x * 256) {
    int t = e / 48, j = e % 48;
    int half_axis, idx;
    if (j < 16) { half_axis = 16; idx = j; } else { half_axis = 32; idx = j - 16; }
    int qd = half_axis / 2;
    int axis = idx / qd, i = idx % qd;
    float inv = powf(10000.f, -(2.f * (float)i) / (float)half_axis);
    float ang = (axis ? (float)(t & 63) : (float)(t >> 6)) * inv;
    float sn, cs;
    sincosf(ang, &sn, &cs);
    p.ROPE[(size_t)e * 2] = cs;
    p.ROPE[(size_t)e * 2 + 1] = sn;
  }
  float* sc2 = smem;
  float* red2 = smem + 17 * 256;
  int kg2 = tid >> 4, col2 = tid & 15;
  for (int u = bid_(); u < 384; u += gridDim.x) {
    int l = u / 192, n0 = (u % 192) * 16;
    float acc[17];
#pragma unroll
    for (int i = 0; i < 17; i++) acc[i] = 0.f;
    for (int kc = 0; kc < 4; kc++) {
      __syncthreads();
      for (int e = tid; e < 17 * 256; e += 256) {
        int bi = e >> 8, k = e & 255;
        float cv = bi < 16 ? p.c[bi * 1024 + kc * 256 + k] : p.c_ctx[kc * 256 + k];
        sc2[e] = cv / (1.f + expf(-cv));
      }
      __syncthreads();
#pragma unroll 4
      for (int kk = 0; kk < 16; kk++) {
        int k = kg2 * 16 + kk;
        float w = p.ada_w[((size_t)l * 1024 + kc * 256 + k) * 3072 + n0 + col2];
#pragma unroll
        for (int bi = 0; bi < 17; bi++) acc[bi] += sc2[bi * 256 + k] * w;
      }
    }
    __syncthreads();
#pragma unroll
    for (int bi = 0; bi < 17; bi++) red2[(kg2 * 17 + bi) * 16 + col2] = acc[bi];
    __syncthreads();
    for (int e = tid; e < 17 * 16; e += 256) {
      int bi = e >> 4, cc = e & 15;
      float sacc = 0.f;
      for (int gq = 0; gq < 16; gq++) sacc += red2[(gq * 17 + bi) * 16 + cc];
      p.MOD[((size_t)l * 17 + bi) * 3072 + n0 + cc] = sacc + p.ada_b[l * 3072 + n0 + cc];
    }
    __syncthreads();
  }
}

struct Job {
  const float* src;
  const float* rs;
  bf16* dst;
  int sld, K, nvalid, npad;
};
DEV Job get_job(PRef p, int l, int j) {
  const float* win = p.w_in + (size_t)l * 1024 * NIN;
  Job jb;
  jb.rs = nullptr;
  jb.sld = NIN;
  jb.K = 1024;
  switch (j) {
    case 0: jb.src = win; jb.dst = p.WT1; jb.nvalid = 1792; jb.npad = 1792; break;
    case 1: jb.src = win + 2304; jb.dst = p.WT1 + (size_t)1792 * 1024; jb.nvalid = 416; jb.npad = 512; break;
    case 2: jb.src = win + 3232; jb.dst = p.WT1 + (size_t)2304 * 1024; jb.nvalid = 768; jb.npad = 768; break;
    case 3: jb.src = win + 1792; jb.dst = p.WT2; jb.nvalid = 512; jb.npad = 512; break;
    case 4: jb.src = win + 2720; jb.dst = p.WT2 + (size_t)512 * 1024; jb.nvalid = 512; jb.npad = 512; break;
    case 5: jb.src = win + 4000; jb.dst = p.WT2 + (size_t)1024 * 1024; jb.nvalid = 512; jb.npad = 512; break;
    case 6: jb.src = win + 4512; jb.dst = p.WT3; jb.nvalid = 3072; jb.npad = 3072; break;
    case 7:
      jb.src = p.b_w_uq + (size_t)l * 256 * 768; jb.rs = p.b_q_ln + l * 256; jb.dst = p.WUQ; jb.sld = 768; jb.K = 256;
      jb.nvalid = 768; jb.npad = 768; break;
    case 8:
      jb.src = p.b_w_ukv + (size_t)l * 128 * 1024; jb.rs = p.b_kv_ln + l * 128; jb.dst = p.WUKV; jb.sld = 1024;
      jb.K = 128; jb.nvalid = 1024; jb.npad = 1024; break;
    case 9: case 10: case 11:
      jb.src = p.w_branch_out + ((size_t)l * 3 + (j - 9)) * 512 * 1024; jb.dst = p.WBO + (size_t)(j - 9) * 1024 * 512;
      jb.sld = 1024; jb.K = 512; jb.nvalid = 1024; jb.npad = 1024; break;
    default:
      jb.src = p.w_out + (size_t)l * 1024 * 1024; jb.dst = p.WOUT; jb.sld = 1024; jb.K = 1024; jb.nvalid = 1024;
      jb.npad = 1024; break;
  }
  return jb;
}
__device__ void phase_wconv(PRef p, int l, float* sm) {
  int tid = tid_();
  int g0 = 0;
  for (int j = 0; j < 13; j++) {
    int jq = j;
    asm volatile("" : "+s"(jq));
    Job jb = get_job(p, l, jq);
    int nn = jb.npad / 64;
    int nt_total = (jb.K / 64) * nn;
    int first = (bid_() - (g0 % (int)gridDim.x) + (int)gridDim.x) % (int)gridDim.x;
    for (int t = first; t < nt_total; t += gridDim.x) {
      int kt = t / nn, nt = t % nn;
      __syncthreads();
      for (int e = tid; e < 4096; e += 256) {
        int i = e >> 6, jj = e & 63;
        int k = kt * 64 + i, n = nt * 64 + jj;
        float v = (n < jb.nvalid) ? jb.src[(size_t)k * jb.sld + n] : 0.f;
        if (jb.rs) v *= jb.rs[k];
        sm[i * 65 + jj] = v;
      }
      __syncthreads();
      for (int e = tid; e < 4096; e += 256) {
        int jj = e >> 6, i = e & 63;
        jb.dst[(size_t)(nt * 64 + jj) * jb.K + kt * 64 + i] = f2bf(sm[i * 65 + jj]);
      }
    }
    g0 += nt_total;
  }
}

__device__ void phase_norm(PRef p, int l, const float* xl, const float* xc, bf16* H, bool skip_ctx) {
  int tid = tid_();
  int wave = tid >> 6, lane = tid & 63;
  int gw = bid_() * 4 + wave, nw = gridDim.x * 4;
  const float* g = p.norm_g + l * 1024;
  for (int R0 = gw; R0 < NROWS; R0 += 2 * nw) {
    f32x4v v[2][4];
    bool ok[2];
    int Rr[2];
#pragma unroll
    for (int u = 0; u < 2; u++) {
      int R = R0 + u * nw;
      Rr[u] = R;
      ok[u] = R < NROWS && !(skip_ctx && (R % TPB) < 256);
      if (ok[u]) {
        const float* xr = xrow_ptr(xl, xc, R);
#pragma unroll
        for (int i = 0; i < 4; i++) v[u][i] = *(const f32x4v*)(xr + i * 256 + lane * 4);
      } else {
#pragma unroll
        for (int i = 0; i < 4; i++) v[u][i] = f32x4v{0.f, 0.f, 0.f, 0.f};
      }
    }
#pragma unroll
    for (int u = 0; u < 2; u++) {
      float ss = 0.f;
#pragma unroll
      for (int i = 0; i < 4; i++) ss += v[u][i].x * v[u][i].x + v[u][i].y * v[u][i].y + v[u][i].z * v[u][i].z + v[u][i].w * v[u][i].w;
      ss = wave_sum(ss);
      if (!ok[u]) continue;
      int R = Rr[u];
      int b = R / TPB, tp = R % TPB;
      int mi = tp < 256 ? 16 : b;
      const float* md = p.MOD + ((size_t)l * 17 + mi) * 3072;
      float rstd = rsqrtf(ss * (1.f / 1024.f) + 1e-6f);
#pragma unroll
      for (int i = 0; i < 4; i++) {
        int col = i * 256 + lane * 4;
        f32x4v gg = *(const f32x4v*)(g + col);
        f32x4v sh = *(const f32x4v*)(md + col);
        f32x4v sc = *(const f32x4v*)(md + 1024 + col);
        float h0 = v[u][i].x * rstd * gg.x * (1.f + sc.x) + sh.x;
        float h1 = v[u][i].y * rstd * gg.y * (1.f + sc.y) + sh.y;
        float h2 = v[u][i].z * rstd * gg.z * (1.f + sc.z) + sh.z;
        float h3 = v[u][i].w * rstd * gg.w * (1.f + sc.w) + sh.w;
        uint2 o;
        o.x = pack2(h0, h1);
        o.y = pack2(h2, h3);
        *(uint2*)(H + (size_t)R * 1024 + col) = o;
      }
    }
  }
}

constexpr int LDT = 72;
template <int NI>
DEV void zero_acc(f32x16 (&acc)[2][NI]) {
#pragma unroll
  for (int a = 0; a < 2; a++)
#pragma unroll
    for (int b = 0; b < NI; b++)
#pragma unroll
      for (int r = 0; r < 16; r++) acc[a][b][r] = 0.f;
}
template <int NI, bool DEEP = true>
DEV void gemm_tile(f32x16 (&acc)[2][NI], const bf16* __restrict__ A, int lda, const bf16* __restrict__ Bt, int ldb,
                   int K, bf16* sA, bf16* sB) {
  int tid = tid_(), lane = tid & 63, wave = tid >> 6;
  int wm = wave >> 1, wn = wave & 1;
  int lr = tid >> 3, lc = (tid & 7) * 8;
  const bf16* Ap = A + (size_t)lr * lda + lc;
  const bf16* Bp = Bt + (size_t)lr * ldb + lc;
  u32x4 ra0[4], rb0[2 * NI], ra1[4], rb1[2 * NI];
#define G_LOAD(RA, RB, KOFF)                                                              \
  {                                                                                       \
    _Pragma("unroll") for (int i = 0; i < 4; i++) RA[i] = *(const u32x4*)(Ap + (size_t)(32 * i) * lda + (KOFF));      \
    _Pragma("unroll") for (int i = 0; i < 2 * NI; i++) RB[i] = *(const u32x4*)(Bp + (size_t)(32 * i) * ldb + (KOFF)); \
  }
#define G_STEP(RA, RB, KNEXT)                                                             \
  {                                                                                       \
    lds_barrier();                                                                        \
    _Pragma("unroll") for (int i = 0; i < 4; i++) *(u32x4*)(sA + (lr + 32 * i) * LDT + lc) = RA[i];      \
    _Pragma("unroll") for (int i = 0; i < 2 * NI; i++) *(u32x4*)(sB + (lr + 32 * i) * LDT + lc) = RB[i]; \
    lds_barrier();                                                                        \
    if ((KNEXT) < K) G_LOAD(RA, RB, KNEXT)                                                \
    _Pragma("unroll") for (int ks = 0; ks < 4; ks++) {                                    \
      bf16x8 af[2], bfr[NI];                                                              \
      _Pragma("unroll") for (int mi = 0; mi < 2; mi++)                                    \
        af[mi] = *(const bf16x8*)(sA + (wm * 64 + mi * 32 + (lane & 31)) * LDT + ks * 16 + (lane >> 5) * 8);          \
      _Pragma("unroll") for (int ni = 0; ni < NI; ni++)                                   \
        bfr[ni] = *(const bf16x8*)(sB + (wn * NI * 32 + ni * 32 + (lane & 31)) * LDT + ks * 16 + (lane >> 5) * 8);    \
      _Pragma("unroll") for (int mi = 0; mi < 2; mi++)                                    \
        _Pragma("unroll") for (int ni = 0; ni < NI; ni++)                                 \
          acc[mi][ni] = __builtin_amdgcn_mfma_f32_32x32x16_bf16(bfr[ni], af[mi], acc[mi][ni], 0, 0, 0);                \
    }                                                                                     \
      \
    if (DEEP) {                                                                           \
    __builtin_amdgcn_sched_group_barrier(0x100, 2 + NI, 0);                               \
    __builtin_amdgcn_sched_group_barrier(0x008, 1, 0);                                    \
    __builtin_amdgcn_sched_group_barrier(0x100, NI == 1 ? 2 : 1, 0);                      \
    _Pragma("unroll") for (int q_ = 0; q_ < (NI == 1 ? 7 : 11); q_++) {                   \
      __builtin_amdgcn_sched_group_barrier(0x008, 1, 0);                                  \
      __builtin_amdgcn_sched_group_barrier(0x100, 1, 0);                                  \
    }                                                                                     \
    __builtin_amdgcn_sched_group_barrier(0x008, NI == 1 ? 0 : 4, 0);                      \
    }                                                                                     \
  }
  G_LOAD(ra0, rb0, 0)
  if (DEEP) {
    if (64 < K) G_LOAD(ra1, rb1, 64)
    for (int k0 = 0; k0 < K; k0 += 128) {
      G_STEP(ra0, rb0, k0 + 128)
      if (k0 + 64 < K) G_STEP(ra1, rb1, k0 + 192)
    }
  } else {
    for (int k0 = 0; k0 < K; k0 += 64) G_STEP(ra0, rb0, k0 + 64)
  }
#undef G_LOAD
#undef G_STEP
}
template <int NI>
DEV void stage_tile(const f32x16 (&acc)[2][NI], bf16* sC) {
  constexpr int LDC = NI * 64 + 8;
  int tid = tid_();
  int lane = tid & 63, wave = tid >> 6;
  int wm = wave >> 1, wn = wave & 1;
  __syncthreads();
#pragma unroll
  for (int mi = 0; mi < 2; mi++)
#pragma unroll
    for (int ni = 0; ni < NI; ni++)
#pragma unroll
      for (int g = 0; g < 4; g++) {
        int row = wm * 64 + mi * 32 + (lane & 31);
        int col = wn * NI * 32 + ni * 32 + 8 * g + 4 * (lane >> 5);
        uint2 v;
        v.x = pack2(acc[mi][ni][4 * g], acc[mi][ni][4 * g + 1]);
        v.y = pack2(acc[mi][ni][4 * g + 2], acc[mi][ni][4 * g + 3]);
        *(uint2*)(sC + row * LDC + col) = v;
      }
  __syncthreads();
}
#define TILE_CHUNKS(NI_, sC_, ...)                                            \
  {                                                                           \
    constexpr int LDC_ = NI_ * 64 + 8;                                        \
    int tid__ = tid_();                                                       \
    _Pragma("unroll") for (int it_ = 0; it_ < NI_ * 4; it_++) {               \
      int c_ = tid__ + it_ * 256;                                             \
      int trow = c_ / (NI_ * 8), tcol = (c_ % (NI_ * 8)) * 8;                 \
      u32x4 cv = *(const u32x4*)(sC_ + trow * LDC_ + tcol);                   \
      __VA_ARGS__                                                             \
    }                                                                         \
  }

__device__ void phase_gemm1(PRef p, bf16* sA, bf16* sB) {
  const int xcd_ = bid_() & 7, per_ = gridDim.x >> 3;
  for (int t = bid_() >> 3; t < 36 * 24; t += per_) {
    int rt = xcd_ + 8 * (t / 24), ct = t % 24;
    f32x16 acc[2][2];
    zero_acc<2>(acc);
    gemm_tile<2>(acc, p.HY + (size_t)rt * 128 * 1024, 1024, p.WT1 + (size_t)ct * 128 * 1024, 1024, 1024, sA, sB);
    bf16* dst;
    int ld, c0;
    if (ct < 14) { dst = p.ZA; ld = 1792; c0 = ct * 128; }
    else if (ct < 18) { dst = p.ZB; ld = 512; c0 = (ct - 14) * 128; }
    else { dst = p.ZC; ld = 768; c0 = (ct - 18) * 128; }
    stage_tile<2>(acc, sA);
    TILE_CHUNKS(2, sA, { *(u32x4*)(dst + (size_t)(rt * 128 + trow) * ld + c0 + tcol) = cv; })
  }
}

__device__ void phase_p3a(PRef p, bf16* sA, bf16* sB, int vb, int vg) {
  const int xcd_ = vb & 7, per_ = vg >> 3;
  for (int t = vb >> 3; t < 36 * 14; t += per_) {
    int rt = xcd_ + 8 * (t / 14), ct = t % 14;
    f32x16 acc[2][2];
    zero_acc<2>(acc);
    if (ct < 6) {
      gemm_tile<2>(acc, p.ZB + (size_t)rt * 128 * 512, 512, p.WUQ + (size_t)ct * 128 * 256, 256, 256, sA, sB);
      stage_tile<2>(acc, sA);
      TILE_CHUNKS(2, sA, { *(u32x4*)(p.Q + (size_t)(rt * 128 + trow) * 768 + ct * 128 + tcol) = cv; })
    } else {
      int c2 = ct - 6;
      gemm_tile<2>(acc, p.ZB + (size_t)rt * 128 * 512 + 256, 512, p.WUKV + (size_t)c2 * 128 * 128, 128, 128, sA, sB);
      stage_tile<2>(acc, sA);
      TILE_CHUNKS(2, sA, { *(u32x4*)(p.KV + (size_t)(rt * 128 + trow) * 1024 + c2 * 128 + tcol) = cv; })
    }
  }
}

DEV float group8_sum(float v) {
  v += dpp_mov<0xB1>(v);
  v += dpp_mov<0x4E>(v);
  v += dpp_mov<0x141>(v);
  return v;
}
DEV float lane_xor2(float v) { return dpp_mov<0x4E>(v); }
DEV float bflo(uint32_t u) { return __uint_as_float(u << 16); }
DEV float bfhi(uint32_t u) { return __uint_as_float(u & 0xffff0000u); }
__device__ void phase_p3b(PRef p, int l, float* smem, int vb, int vg) {
  (void)smem;
  int tid = tid_();
  int wave = tid >> 6, lane = tid & 63;
  int gw = vb * 4 + wave, nw = vg * 4;
  int h = lane >> 3, sub = lane & 7;
  int hfB = (sub >> 1) & 1;
  const float* qn_g = p.b_qn_g + l * 96;
  const float* kn_g = p.b_kn_g + l * 96;
  const float* cq_g = p.c_qn_g + l * 64;
  const float* ck_g = p.c_kn_g + l * 64;
  float gqN[8], gqR[4], gkN[16], gkR[4], gkRp[4], gcq[8], gck[8];
#pragma unroll
  for (int j = 0; j < 8; j++) { gqN[j] = qn_g[sub * 8 + j]; gcq[j] = cq_g[sub * 8 + j]; gck[j] = ck_g[sub * 8 + j]; }
#pragma unroll
  for (int j = 0; j < 4; j++) {
    gqR[j] = qn_g[64 + sub * 4 + j];
    gkR[j] = kn_g[64 + sub * 4 + j];
    gkRp[j] = kn_g[64 + ((sub ^ 2) * 4) + j];
  }
#pragma unroll
  for (int j = 0; j < 16; j++) gkN[j] = kn_g[(sub & 3) * 16 + j];
  for (int R = gw; R < NROWS; R += nw) {
    int tp = R % TPB;
    bool lat = tp >= 256;
    int t = lat ? tp - 256 : 0;
    const bf16* zb = p.ZB + (size_t)R * 512;
    bf16* q = p.Q + (size_t)R * 768;
    bf16* kv = p.KV + (size_t)R * 1024;
    bf16* kr = p.KR + (size_t)R * 256;
    bf16* zc = p.ZC + (size_t)R * 768;
    const float* tabB = p.ROPE + (size_t)t * 96;
    const float* tabC = tabB + 32;
    uint2 cq2 = *(const uint2*)(zb + lane * 4);
    uint32_t ckv2 = *(const uint32_t*)(zb + 256 + lane * 2);
    uint2 krO = *(const uint2*)(zb + 384 + sub * 4);
    uint2 krP = *(const uint2*)(zb + 384 + (sub ^ 2) * 4);
    u32x4 qN = *(const u32x4*)(q + h * 96 + sub * 8);
    uint2 qR = *(const uint2*)(q + h * 96 + 64 + sub * 4);
    u32x4 kv0 = *(const u32x4*)(kv + h * 128 + sub * 16);
    u32x4 kv1 = *(const u32x4*)(kv + h * 128 + sub * 16 + 8);
    u32x4 cqv = *(const u32x4*)(zc + h * 64 + sub * 8);
    u32x4 ckv = *(const u32x4*)(zc + 512 + (h & 1) * 64 + sub * 8);
    int axis = sub >> 2;
    f32x4v tB0 = *(const f32x4v*)(tabB + 2 * (axis * 8 + (sub & 1) * 4));
    f32x4v tB1 = *(const f32x4v*)(tabB + 2 * (axis * 8 + (sub & 1) * 4) + 4);
    f32x4v tC[4];
#pragma unroll
    for (int i = 0; i < 4; i++) tC[i] = *(const f32x4v*)(tabC + 2 * (axis * 16 + (sub & 1) * 8) + 4 * i);
    float ss = bflo(cq2.x) * bflo(cq2.x) + bfhi(cq2.x) * bfhi(cq2.x) + bflo(cq2.y) * bflo(cq2.y) + bfhi(cq2.y) * bfhi(cq2.y);
    float rq = rsqrtf(wave_sum(ss) * (1.f / 256.f) + 1e-6f);
    ss = bflo(ckv2) * bflo(ckv2) + bfhi(ckv2) * bfhi(ckv2);
    float rkv = rsqrtf(wave_sum(ss) * (1.f / 128.f) + 1e-6f);
    float krv[4] = {bflo(krO.x), bfhi(krO.x), bflo(krO.y), bfhi(krO.y)};
    float krp[4] = {bflo(krP.x), bfhi(krP.x), bflo(krP.y), bfhi(krP.y)};
    float sskr = group8_sum(krv[0] * krv[0] + krv[1] * krv[1] + krv[2] * krv[2] + krv[3] * krv[3]);
    float csB[4] = {tB0.x, tB0.z, tB1.x, tB1.z}, snB[4] = {tB0.y, tB0.w, tB1.y, tB1.w};
    {
      float vN[8], vR[4];
#pragma unroll
      for (int j = 0; j < 4; j++) { vN[2 * j] = bflo(qN[j]) * rq; vN[2 * j + 1] = bfhi(qN[j]) * rq; }
      vR[0] = bflo(qR.x) * rq; vR[1] = bfhi(qR.x) * rq; vR[2] = bflo(qR.y) * rq; vR[3] = bfhi(qR.y) * rq;
      float s2 = 0.f;
#pragma unroll
      for (int j = 0; j < 8; j++) s2 += vN[j] * vN[j];
#pragma unroll
      for (int j = 0; j < 4; j++) s2 += vR[j] * vR[j];
      float r = rsqrtf(group8_sum(s2) * (1.f / 96.f) + 1e-6f);
      u32x4 oN;
#pragma unroll
      for (int j = 0; j < 4; j++) oN[j] = pack2(vN[2 * j] * r * gqN[2 * j], vN[2 * j + 1] * r * gqN[2 * j + 1]);
      float oR[4];
#pragma unroll
      for (int j = 0; j < 4; j++) {
        float own = vR[j] * r * gqR[j];
        float par = lane_xor2(own);
        float x1 = hfB ? par : own, x2 = hfB ? own : par;
        float ro = hfB ? x1 * snB[j] + x2 * csB[j] : x1 * csB[j] - x2 * snB[j];
        oR[j] = lat ? ro : own;
      }
      *(u32x4*)(q + h * 96 + sub * 8) = oN;
      *(uint2*)(q + h * 96 + 64 + sub * 4) = make_uint2(pack2(oR[0], oR[1]), pack2(oR[2], oR[3]));
    }
    {
      float e16[16];
#pragma unroll
      for (int j = 0; j < 4; j++) {
        e16[2 * j] = bflo(kv0[j]) * rkv; e16[2 * j + 1] = bfhi(kv0[j]) * rkv;
        e16[8 + 2 * j] = bflo(kv1[j]) * rkv; e16[8 + 2 * j + 1] = bfhi(kv1[j]) * rkv;
      }
      float s2 = 0.f;
#pragma unroll
      for (int j = 0; j < 16; j++) s2 += e16[j] * e16[j];
      if (sub >= 4) s2 = 0.f;
      float rk = rsqrtf((group8_sum(s2) + sskr) * (1.f / 96.f) + 1e-6f);
      u32x4 o0, o1;
#pragma unroll
      for (int j = 0; j < 4; j++) {
        float a0 = e16[2 * j], a1 = e16[2 * j + 1], b0 = e16[8 + 2 * j], b1 = e16[8 + 2 * j + 1];
        if (sub < 4) {
          a0 *= rk * gkN[2 * j]; a1 *= rk * gkN[2 * j + 1];
          b0 *= rk * gkN[8 + 2 * j]; b1 *= rk * gkN[8 + 2 * j + 1];
        }
        o0[j] = pack2(a0, a1);
        o1[j] = pack2(b0, b1);
      }
      *(u32x4*)(kv + h * 128 + sub * 16) = o0;
      *(u32x4*)(kv + h * 128 + sub * 16 + 8) = o1;
      float oR[4];
#pragma unroll
      for (int j = 0; j < 4; j++) {
        float own = krv[j] * rk * gkR[j];
        float par = krp[j] * rk * gkRp[j];
        float x1 = hfB ? par : own, x2 = hfB ? own : par;
        float ro = hfB ? x1 * snB[j] + x2 * csB[j] : x1 * csB[j] - x2 * snB[j];
        oR[j] = lat ? ro : own;
      }
      *(uint2*)(kr + h * 32 + sub * 4) = make_uint2(pack2(oR[0], oR[1]), pack2(oR[2], oR[3]));
    }
    {
      float csC[8], snC[8];
#pragma unroll
      for (int i = 0; i < 4; i++) { csC[2 * i] = tC[i].x; snC[2 * i] = tC[i].y; csC[2 * i + 1] = tC[i].z; snC[2 * i + 1] = tC[i].w; }
#pragma unroll
      for (int pass = 0; pass < 2; pass++) {
        u32x4 raw = pass == 0 ? cqv : ckv;
        float v8[8];
#pragma unroll
        for (int j = 0; j < 4; j++) { v8[2 * j] = bflo(raw[j]); v8[2 * j + 1] = bfhi(raw[j]); }
        float s2 = 0.f;
#pragma unroll
        for (int j = 0; j < 8; j++) s2 += v8[j] * v8[j];
        float r = rsqrtf(group8_sum(s2) * (1.f / 64.f) + 1e-6f);
        float o8[8];
#pragma unroll
        for (int j = 0; j < 8; j++) {
          float own = v8[j] * r * (pass == 0 ? gcq[j] : gck[j]);
          float par = lane_xor2(own);
          float x1 = hfB ? par : own, x2 = hfB ? own : par;
          float ro = hfB ? x1 * snC[j] + x2 * csC[j] : x1 * csC[j] - x2 * snC[j];
          o8[j] = lat ? ro : own;
        }
        u32x4 ov;
#pragma unroll
        for (int j = 0; j < 4; j++) ov[j] = pack2(o8[2 * j], o8[2 * j + 1]);
        if (pass == 0) *(u32x4*)(zc + h * 64 + sub * 8) = ov;
        else if (lane < 16) *(u32x4*)(zc + 512 + h * 64 + sub * 8) = ov;
      }
    }
  }
}

typedef short s16x4 __attribute__((ext_vector_type(4)));
struct AttnSm {
  bf16 K[128 * 104];
  bf16 V[128 * 96];
};
template <int DQK>
__device__ void attn_item(const bf16* Qp, int ldq, const bf16* K1, int ldk1, const bf16* K2, int ldk2, const bf16* V,
                          int ldv, int seg0_row, int seg0_tiles, int seg1_row, int seg1_tiles, int qrow0, bool masked0,
                          float scale, bool has_sink, float sink, bf16* O, int ldo, AttnSm* sm, const float* kgain) {
  constexpr int NKS = DQK / 16;
  constexpr int CPK = DQK / 8;
  int tid = tid_(), lane = tid & 63, wave = tid >> 6;
  int hh = lane >> 5;
  int qi = wave * 32 + (lane & 31);
  int qrow = qrow0 + qi;
  bf16x8 qf[NKS];
#pragma unroll
  for (int ks = 0; ks < NKS; ks++) qf[ks] = *(const bf16x8*)(Qp + (size_t)qi * ldq + ks * 16 + hh * 8);
  f32x16 o[2];
#pragma unroll
  for (int db = 0; db < 2; db++)
#pragma unroll
    for (int r = 0; r < 16; r++) o[db][r] = 0.f;
  const float scale2 = scale * 1.4426950408889634f;
  float gmax = 0.f;
  for (int dd = 0; dd < DQK; dd++) gmax = fmaxf(gmax, fabsf(kgain[dd]));
  float qn2 = 0.f;
#pragma unroll
  for (int ks = 0; ks < NKS; ks++)
#pragma unroll
    for (int j = 0; j < 8; j++) { float qv = bf2f((bf16)qf[ks][j]); qn2 += qv * qv; }
  {
    u32x2v r2 = __builtin_amdgcn_permlane32_swap(__float_as_uint(qn2), __float_as_uint(qn2), false, false);
    qn2 = __uint_as_float(r2[0]) + __uint_as_float(r2[1]);
  }
  const float m = fmaxf(sqrtf(qn2) * sqrtf((float)DQK) * gmax * 1.01f * scale2, has_sink ? sink * 1.4426950408889634f : -1e30f);
  float lsum = has_sink ? __builtin_amdgcn_exp2f(sink * 1.4426950408889634f - m) : 0.f;
  seg0_tiles >>= 1;
  seg1_tiles >>= 1;
  int ntiles = seg0_tiles + seg1_tiles;
  constexpr int KCH = (128 * CPK) / 256;
  u32x4 kreg[KCH], vreg[4];
  auto issue_loads = [&](int tt) {
    int krow0 = tt < seg0_tiles ? seg0_row + tt * 128 : seg1_row + (tt - seg0_tiles) * 128;
#pragma unroll
    for (int it = 0; it < KCH; it++) {
      int c = tid + it * 256;
      int key = c / CPK, ch = c % CPK;
      const bf16* src = ch < 8 ? K1 + (size_t)(krow0 + key) * ldk1 + ch * 8 : K2 + (size_t)(krow0 + key) * ldk2 + (ch - 8) * 8;
      kreg[it] = *(const u32x4*)src;
    }
#pragma unroll
    for (int it = 0; it < 4; it++) {
      int c = tid + it * 256;
      int key = c >> 3, ch = c & 7;
      vreg[it] = *(const u32x4*)(V + (size_t)(krow0 + key) * ldv + ch * 8);
    }
  };
  issue_loads(0);
  for (int tt = 0; tt < ntiles; tt++) {
    int krow0 = tt < seg0_tiles ? seg0_row + tt * 128 : seg1_row + (tt - seg0_tiles) * 128;
    bool msk = masked0 && tt < seg0_tiles;
    lds_barrier();
#pragma unroll
    for (int it = 0; it < KCH; it++) {
      int c = tid + it * 256;
      int key = c / CPK, ch = c % CPK;
      *(u32x4*)(sm->K + key * 104 + ch * 8) = kreg[it];
    }
#pragma unroll
    for (int it = 0; it < 4; it++) {
      int c = tid + it * 256;
      int key = c >> 3, ch = c & 7;
      *(u32x4*)(sm->V + key * 96 + ch * 8) = vreg[it];
    }
    lds_barrier();
    if (tt + 1 < ntiles) issue_loads(tt + 1);
    f32x16 s[4];
#pragma unroll
    for (int kb = 0; kb < 4; kb++) {
#pragma unroll
      for (int r = 0; r < 16; r++) s[kb][r] = 0.f;
#pragma unroll
      for (int ks = 0; ks < NKS; ks++) {
        bf16x8 a = *(const bf16x8*)(sm->K + (kb * 32 + (lane & 31)) * 104 + ks * 16 + hh * 8);
        s[kb] = __builtin_amdgcn_mfma_f32_32x32x16_bf16(a, qf[ks], s[kb], 0, 0, 0);
      }
    }
    float psum = 0.f;
#pragma unroll
    for (int kb = 0; kb < 4; kb++)
#pragma unroll
      for (int r = 0; r < 16; r++) {
        float v = s[kb][r];
        if (msk) {
          int key = kb * 32 + (r & 3) + 8 * (r >> 2) + 4 * hh;
          int d = (krow0 + key) - qrow;
          if (d > 128 || d < -128) v = -1e30f;
        }
        float pv = __builtin_amdgcn_exp2f(__builtin_fmaf(v, scale2, -m));
        s[kb][r] = pv;
        psum += pv;
      }
    lsum += psum;
#pragma unroll
    for (int kb = 0; kb < 4; kb++)
#pragma unroll
      for (int s2 = 0; s2 < 2; s2++) {
        u32x4 pfu;
#pragma unroll
        for (int j = 0; j < 4; j++) pfu[j] = pack2(s[kb][8 * s2 + 2 * j], s[kb][8 * s2 + 2 * j + 1]);
        bf16x8 pf = __builtin_bit_cast(bf16x8, pfu);
#pragma unroll
        for (int db = 0; db < 2; db++) {
          typedef __attribute__((address_space(3))) s16x4* lds_s4p;
          const bf16* vb = sm->V + (kb * 32 + 16 * s2 + 4 * hh + ((lane & 15) >> 2)) * 96 + db * 32 + 16 * ((lane >> 4) & 1) + 4 * (lane & 3);
          s16x4 lo = __builtin_amdgcn_ds_read_tr16_b64_v4i16((lds_s4p)vb);
          s16x4 hi = __builtin_amdgcn_ds_read_tr16_b64_v4i16((lds_s4p)(vb + 8 * 96));
          bf16x8 vf;
          vf[0] = lo[0]; vf[1] = lo[1]; vf[2] = lo[2]; vf[3] = lo[3];
          vf[4] = hi[0]; vf[5] = hi[1]; vf[6] = hi[2]; vf[7] = hi[3];
          o[db] = __builtin_amdgcn_mfma_f32_32x32x16_bf16(vf, pf, o[db], 0, 0, 0);
        }
      }
  }
  {
    u32x2v r2 = __builtin_amdgcn_permlane32_swap(__float_as_uint(lsum), __float_as_uint(lsum), false, false);
    lsum = __uint_as_float(r2[0]) + __uint_as_float(r2[1]);
    if (has_sink) lsum -= __builtin_amdgcn_exp2f(sink * 1.4426950408889634f - m);
  }
  float inv = 1.f / lsum;
#pragma unroll
  for (int db = 0; db < 2; db++)
#pragma unroll
    for (int g = 0; g < 4; g++) {
      int dv = db * 32 + 8 * g + 4 * hh;
      uint2 ov;
      ov.x = pack2(o[db][4 * g] * inv, o[db][4 * g + 1] * inv);
      ov.y = pack2(o[db][4 * g + 2] * inv, o[db][4 * g + 3] * inv);
      *(uint2*)(O + (size_t)qi * ldo + dv) = ov;
    }
}

__device__ void attn_dispatch(PRef p, int l, int it, AttnSm* sm) {
  const int nA = 2048, nB = (l == 0) ? 256 : 0, nC = 2048;
  if (it < nA + nB) {
    int b, h, row0, ktiles;
    if (it < nA) { b = it >> 7; h = (it >> 4) & 7; int qt = it & 15; row0 = b * TPB + 256 + qt * 128; ktiles = 36; }
    else { int j = it - nA; b = j >> 4; h = (j >> 1) & 7; int qt = j & 1; row0 = b * TPB + qt * 128; ktiles = 4; }
    attn_item<96>(p.Q + (size_t)row0 * 768 + h * 96, 768, p.KV + h * 128, 1024, p.KR + h * 32, 256, p.KV + h * 128 + 64,
                  1024, b * TPB, ktiles, 0, 0, row0, false, 0.10206207261596575f, false, 0.f,
                  p.ZB + (size_t)row0 * 512 + h * 64, 512, sm, p.b_kn_g + l * 96);
  } else {
    int j = it - nA - nB;
    float sink;
    int b, h, row0, s0row, s0t, s1row, s1t;
    bool msk;
    if (j < nC) {
      b = j >> 7; h = (j >> 4) & 7; int qt = j & 15;
      row0 = b * TPB + 256 + qt * 128;
      int lo = (qt - 1) * 128; if (lo < 0) lo = 0;
      int hi = (qt + 2) * 128; if (hi > 2048) hi = 2048;
      s0row = b * TPB + 256 + lo; s0t = (hi - lo) / 64; s1row = b * TPB; s1t = 4; msk = true;
    } else {
      int jj = j - nC;
      b = jj >> 4; h = (jj >> 1) & 7; int qt = jj & 1;
      row0 = b * TPB + qt * 128; s0row = b * TPB; s0t = 4; s1row = 0; s1t = 0; msk = false;
    }
    sink = p.c_sink[l * 8 + h];
    int kvh = h >> 2;
    attn_item<64>(p.ZC + (size_t)row0 * 768 + h * 64, 768, p.ZC + 512 + kvh * 64, 768, nullptr, 0, p.ZC + 640 + kvh * 64, 768,
                  s0row, s0t, s1row, s1t, row0, msk, 0.125f, true, sink, p.ZC + (size_t)row0 * 768 + h * 64, 768, sm, p.c_kn_g + l * 64);
  }
}

struct ScanRec {
  float w[64], kk[64], kka[64], kd[64], r[64], v[64];
};
struct ScanSm {
  ScanRec rec[2][16];
  float st[4][2][64];
  float xch[2 * 2 * 64 * 4];
};
DEV int scan_row(int b, int d, int s) {
  bool isctx = s < 256;
  int pos = isctx ? (d ? 255 - s : s) : (d ? 2047 - (s - 256) : s - 256);
  return b * TPB + (isctx ? 0 : 256) + pos;
}
struct PrepConst {
  int cols[5];
  float mup[5], mun[5];
  float w0v, a0v, kkc, kac, rkc;
  uint32_t wu[32], au[32];
};
struct PrepRaw {
  bf16 zc[5], zp[5], zn[5];
  float fp, fn;
  int row;
};
DEV void prep_load(PRef p, const PrepConst& pc, int b, int d, int s, PrepRaw& rw) {
  bool isctx = s < 256;
  int pos = isctx ? (d ? 255 - s : s) : (d ? 2047 - (s - 256) : s - 256);
  int seglen = isctx ? 256 : 2048;
  int row = b * TPB + (isctx ? 0 : 256) + pos;
  rw.row = row;
  bool hp = pos > 0, hn = pos < seglen - 1;
  const bf16* z = p.ZA + (size_t)row * 1792;
  const bf16* zpp = hp ? z - 1792 : z;
  const bf16* znp = hn ? z + 1792 : z;
  rw.fp = hp ? 1.f : 0.f;
  rw.fn = hn ? 1.f : 0.f;
#pragma unroll
  for (int i = 0; i < 5; i++) {
    int col = pc.cols[i];
    rw.zc[i] = z[col];
    rw.zp[i] = zpp[col];
    rw.zn[i] = znp[col];
  }
}
typedef __bf16 bf16v2 __attribute__((ext_vector_type(2)));
DEV float dot2bf(uint32_t a, uint32_t b, float c) {
  return __builtin_amdgcn_fdot2_f32_bf16(*(bf16v2*)&a, *(bf16v2*)&b, c, false);
}
DEV void prep_compute(PRef p, const PrepConst& pc, const PrepRaw& rw, int h, int d, ScanRec* rc, float* stw, int lane) {
  float vals[5];
#pragma unroll
  for (int i = 0; i < 5; i++) {
    float zc = bf2f(rw.zc[i]), zp = rw.fp * bf2f(rw.zp[i]), zn = rw.fn * bf2f(rw.zn[i]);
    vals[i] = zc + pc.mup[i] * (zp - zc) + pc.mun[i] * (zn - zc);
  }
  float rv = vals[0], kv = vals[1], vv = vals[2];
  float th = 1.f - __fdividef(2.f, 1.f + __expf(2.f * vals[3]));
  bf16* stb = (bf16*)stw;
  wbar();
  stb[lane] = f2bf(th);
  stb[64 + lane] = f2bf(vals[4]);
  wbar();
  float wl0 = pc.w0v, wl1 = 0.f, al0 = pc.a0v, al1 = 0.f;
  const uint4* st4 = (const uint4*)stw;
#pragma unroll
  for (int g = 0; g < 8; g++) {
    uint4 t = st4[g];
    uint4 u = st4[8 + g];
    wl0 = dot2bf(t.x, pc.wu[4 * g], wl0);
    wl1 = dot2bf(t.y, pc.wu[4 * g + 1], wl1);
    wl0 = dot2bf(t.z, pc.wu[4 * g + 2], wl0);
    wl1 = dot2bf(t.w, pc.wu[4 * g + 3], wl1);
    al0 = dot2bf(u.x, pc.au[4 * g], al0);
    al1 = dot2bf(u.y, pc.au[4 * g + 1], al1);
    al0 = dot2bf(u.z, pc.au[4 * g + 2], al0);
    al1 = dot2bf(u.w, pc.au[4 * g + 3], al1);
  }
  float wl = wl0 + wl1, al = al0 + al1;
  float zz = -wl;
  float sp = zz > 20.f ? zz : __logf(1.f + __expf(zz));
  float wlog = -sp - 0.5f;
  float dec = __expf(-__expf(wlog));
  float a = __fdividef(1.f, 1.f + __expf(-al));
  float kkv = kv * pc.kkc;
  float ssk = wave_sum(kkv * kkv);
  kkv *= rsqrtf(fmaxf(ssk, 1e-24f));
  float kdv = kv * (1.f + (a - 1.f) * pc.kac);
  float bon = wave_sum(rv * kdv * pc.rkc);
  rc->w[lane] = dec;
  rc->kk[lane] = kkv;
  rc->kka[lane] = kkv * a;
  rc->kd[lane] = kdv;
  rc->r[lane] = rv;
  rc->v[lane] = vv;
  if (lane == 0) p.SB[(size_t)rw.row * 16 + d * 8 + h] = bon;
}
DEV void prep_compute2(PRef p, const PrepConst& pc, const PrepRaw& rwA, const PrepRaw& rwB, int h, int d,
                       ScanRec* rcA, ScanRec* rcB, float* stw, int lane, float& Dprev) {
  float valsA[5], valsB[5];
#pragma unroll
  for (int i = 0; i < 5; i++) {
    float zc = bf2f(rwA.zc[i]), zp = rwA.fp * bf2f(rwA.zp[i]), zn = rwA.fn * bf2f(rwA.zn[i]);
    valsA[i] = zc + pc.mup[i] * (zp - zc) + pc.mun[i] * (zn - zc);
    float zc2 = bf2f(rwB.zc[i]), zp2 = rwB.fp * bf2f(rwB.zp[i]), zn2 = rwB.fn * bf2f(rwB.zn[i]);
    valsB[i] = zc2 + pc.mup[i] * (zp2 - zc2) + pc.mun[i] * (zn2 - zc2);
  }
  float thA = 1.f - __fdividef(2.f, 1.f + __expf(2.f * valsA[3]));
  float thB = 1.f - __fdividef(2.f, 1.f + __expf(2.f * valsB[3]));
  bf16* stb = (bf16*)stw;
  wbar();
  stb[lane] = f2bf(thA);
  stb[64 + lane] = f2bf(valsA[4]);
  stb[128 + lane] = f2bf(thB);
  stb[192 + lane] = f2bf(valsB[4]);
  wbar();
  float wA0 = pc.w0v, wA1 = 0.f, aA0 = pc.a0v, aA1 = 0.f;
  float wB0 = pc.w0v, wB1 = 0.f, aB0 = pc.a0v, aB1 = 0.f;
  const uint4* st4 = (const uint4*)stw;
#pragma unroll
  for (int g = 0; g < 8; g++) {
    uint4 tA = st4[g], uA = st4[8 + g], tB = st4[16 + g], uB = st4[24 + g];
    uint32_t w0 = pc.wu[4 * g], w1 = pc.wu[4 * g + 1], w2 = pc.wu[4 * g + 2], w3 = pc.wu[4 * g + 3];
    uint32_t u0 = pc.au[4 * g], u1 = pc.au[4 * g + 1], u2 = pc.au[4 * g + 2], u3 = pc.au[4 * g + 3];
    wA0 = dot2bf(tA.x, w0, wA0); wB0 = dot2bf(tB.x, w0, wB0);
    wA1 = dot2bf(tA.y, w1, wA1); wB1 = dot2bf(tB.y, w1, wB1);
    wA0 = dot2bf(tA.z, w2, wA0); wB0 = dot2bf(tB.z, w2, wB0);
    wA1 = dot2bf(tA.w, w3, wA1); wB1 = dot2bf(tB.w, w3, wB1);
    aA0 = dot2bf(uA.x, u0, aA0); aB0 = dot2bf(uB.x, u0, aB0);
    aA1 = dot2bf(uA.y, u1, aA1); aB1 = dot2bf(uB.y, u1, aB1);
    aA0 = dot2bf(uA.z, u2, aA0); aB0 = dot2bf(uB.z, u2, aB0);
    aA1 = dot2bf(uA.w, u3, aA1); aB1 = dot2bf(uB.w, u3, aB1);
  }
  float zzA = -(wA0 + wA1), zzB = -(wB0 + wB1);
  float spA = zzA > 20.f ? zzA : __logf(1.f + __expf(zzA));
  float spB = zzB > 20.f ? zzB : __logf(1.f + __expf(zzB));
  float decA = __expf(-__expf(-spA - 0.5f)), decB = __expf(-__expf(-spB - 0.5f));
  float aA = __fdividef(1.f, 1.f + __expf(-(aA0 + aA1))), aB = __fdividef(1.f, 1.f + __expf(-(aB0 + aB1)));
  float kkA = valsA[1] * pc.kkc, kkB = valsB[1] * pc.kkc;
  float ssA = wave_sum(kkA * kkA), ssB = wave_sum(kkB * kkB);
  kkA *= rsqrtf(fmaxf(ssA, 1e-24f));
  kkB *= rsqrtf(fmaxf(ssB, 1e-24f));
  float kdA = valsA[1] * (1.f + (aA - 1.f) * pc.kac), kdB = valsB[1] * (1.f + (aB - 1.f) * pc.kac);
  float bonA = wave_sum(valsA[0] * kdA * pc.rkc), bonB = wave_sum(valsB[0] * kdB * pc.rkc);
  float DA = Dprev * decA, DB = DA * decB;
  float iDA = __fdividef(1.f, DA), iDB = __fdividef(1.f, DB);
  rcA->w[lane] = DA; rcB->w[lane] = DB;
  rcA->kk[lane] = kkA * Dprev; rcB->kk[lane] = kkB * DA;
  rcA->kka[lane] = kkA * aA * iDA; rcB->kka[lane] = kkB * aB * iDB;
  rcA->kd[lane] = kdA * iDA; rcB->kd[lane] = kdB * iDB;
  rcA->r[lane] = valsA[0] * DA; rcB->r[lane] = valsB[0] * DB;
  rcA->v[lane] = valsA[2]; rcB->v[lane] = valsB[2];
  Dprev = DB;
  if (lane == 0) {
    p.SB[(size_t)rwA.row * 16 + d * 8 + h] = bonA;
    p.SB[(size_t)rwB.row * 16 + d * 8 + h] = bonB;
  }
}
#define CBAR asm volatile("" ::: "memory")
#define PIN2(x, y) asm volatile("" : "+v"(x), "+v"(y) : : "memory")
template <int G>
DEV void ldg(f32x4v (&bb)[8], const ScanRec* rc, int kh) {
  if (G < 2) {
#pragma unroll
    for (int q = 0; q < 4; q++) bb[q] = *(const f32x4v*)&rc->kk[32 * kh + 16 * G + 4 * q];
  } else {
    constexpr int o = G - 2;
#pragma unroll
    for (int jj = 0; jj < 2; jj++) {
      int k0 = 32 * kh + 4 * (2 * o + jj);
      bb[4 * jj + 0] = *(const f32x4v*)&rc->w[k0];
      bb[4 * jj + 1] = *(const f32x4v*)&rc->kka[k0];
      bb[4 * jj + 2] = *(const f32x4v*)&rc->kd[k0];
      bb[4 * jj + 3] = *(const f32x4v*)&rc->r[k0];
    }
  }
}
template <int G>
DEV void cmpg(const f32x4v (&bb)[8], float2v (&S)[16], float2v& a0, float2v& a1, float nsa, float vv, float2v& y0, float2v& y1) {
  if (G < 2) {
#pragma unroll
    for (int q = 0; q < 4; q++) {
      int j = 4 * G + q;
      a0 += S[2 * j] * float2v{bb[q].x, bb[q].y};
      a1 += S[2 * j + 1] * float2v{bb[q].z, bb[q].w};
    }
  } else {
    constexpr int o = G - 2;
#pragma unroll
    for (int jj = 0; jj < 2; jj++) {
      int j = 2 * o + jj;
      f32x4v w4 = bb[4 * jj], q4 = bb[4 * jj + 1], d4 = bb[4 * jj + 2], r4 = bb[4 * jj + 3];
      float2v s0 = S[2 * j] * float2v{w4.x, w4.y} + nsa * float2v{q4.x, q4.y} + vv * float2v{d4.x, d4.y};
      float2v s1 = S[2 * j + 1] * float2v{w4.z, w4.w} + nsa * float2v{q4.z, q4.w} + vv * float2v{d4.z, d4.w};
      S[2 * j] = s0;
      S[2 * j + 1] = s1;
      y0 += s0 * float2v{r4.x, r4.y};
      y1 += s1 * float2v{r4.z, r4.w};
    }
  }
}
DEV void scan_publish(f32x4v* mine, float sa_p, float y_p, int tag) {
  f32x4v v;
  v.x = sa_p; v.y = y_p; v.z = __int_as_float(tag); v.w = 0.f;
  *mine = v;
  asm volatile("" ::: "memory");
}
DEV void scan_collect(const f32x4v* theirs, int tag, float& sa_o, float& y_o) {
  f32x4v o;
  while (true) {
    o = *(const volatile __attribute__((address_space(3))) f32x4v*)theirs;
    if (__all(__float_as_int(o.z) == tag)) break;
  }
  asm volatile("" ::: "memory");
  sa_o = o.x;
  y_o = o.y;
}
#define PIN4(a, b, c, d) asm volatile("" : "+v"(a), "+v"(b), "+v"(c), "+v"(d) : : "memory")
#define SCAN_G(G, BUFC, BUFL)                                                  \
  ldg<((G) + 2) % 6>(BUFL, rc, kh);                                            \
  CBAR;                                                                        \
  cmpg<G>(BUFC, S, a0, a1, nsa, vv, y0, y1);                                   \
  PIN2(a0, a1);
#define SCAN_PRE(O, BUFC, BUFL, LDSTMT, KQ)                                    \
  LDSTMT;                                                                      \
  CBAR;                                                                        \
  _Pragma("unroll") for (int jj = 0; jj < 2; jj++) {                           \
    int j = 2 * (O) + jj;                                                      \
    f32x4v w4 = BUFC[4 * jj], d4 = BUFC[4 * jj + 2];                           \
    S[2 * j] = S[2 * j] * float2v{w4.x, w4.y} + vv * float2v{d4.x, d4.y};      \
    S[2 * j + 1] = S[2 * j + 1] * float2v{w4.z, w4.w} + vv * float2v{d4.z, d4.w}; \
    KQ[2 * jj] = BUFC[4 * jj + 1];                                             \
    KQ[2 * jj + 1] = BUFC[4 * jj + 3];                                         \
  }                                                                            \
  PIN4(S[4 * (O)], S[4 * (O) + 1], S[4 * (O) + 2], S[4 * (O) + 3]);
#define SCAN_POST(O, KQ)                                                       \
  _Pragma("unroll") for (int jj = 0; jj < 2; jj++) {                           \
    int j = 2 * (O) + jj;                                                      \
    f32x4v q4 = KQ[2 * jj], r4 = KQ[2 * jj + 1];                               \
    float2v s0 = S[2 * j] + nsa * float2v{q4.x, q4.y};                         \
    float2v s1 = S[2 * j + 1] + nsa * float2v{q4.z, q4.w};                     \
    S[2 * j] = s0;                                                             \
    S[2 * j + 1] = s1;                                                         \
    y0 += s0 * float2v{r4.x, r4.y};                                            \
    y1 += s1 * float2v{r4.z, r4.w};                                            \
  }
__device__ void scan_chain(PRef p, int l, int chain, ScanSm* sm) {
  int b = chain >> 4, h = (chain >> 1) & 7, d = chain & 1;
  int tid = tid_(), wave = tid >> 6, lane = tid & 63;
  f32x4v* xch = (f32x4v*)sm->xch;
  __syncthreads();
  if (wave < 2) {
    xch[(0 * 2 + wave) * 64 + lane] = f32x4v{0.f, 0.f, 0.f, 0.f};
    xch[(1 * 2 + wave) * 64 + lane] = f32x4v{0.f, 0.f, 0.f, 0.f};
  }
  __syncthreads();
  if (wave < 2) __builtin_amdgcn_s_setprio(3); else __builtin_amdgcn_s_setprio(3);
  if (wave < 2) {
    const int kh = wave;
    float S[32];
#pragma unroll
    for (int j = 0; j < 32; j++) S[j] = 0.f;
    bf16* Y = p.HY + (size_t)d * NROWS * 512 + h * 64 + lane;
    float yprev = 0.f;
    int rowcur = b * TPB + (d ? 255 : 0), rowprev = rowcur;
    const int rstep = d ? -1 : 1;
    const int ko = 32 * kh + (lane & 15);
    float Akk0, Akk1, Aw0, Aw1, Aq0, Aq1, Ad0, Ad1, Ar0, Ar1, Av;
    float Bkk0, Bkk1, Bw0, Bw1, Bq0, Bq1, Bd0, Bd1, Br0, Br1, Bv;
#define LDSET(P, RC)                                                           \
  P##kk0 = (RC)->kk[ko]; P##kk1 = (RC)->kk[ko + 16];                           \
  P##w0 = (RC)->w[ko]; P##w1 = (RC)->w[ko + 16];                               \
  P##q0 = (RC)->kka[ko]; P##q1 = (RC)->kka[ko + 16];                           \
  P##d0 = (RC)->kd[ko]; P##d1 = (RC)->kd[ko + 16];                             \
  P##r0 = (RC)->r[ko]; P##r1 = (RC)->r[ko + 16];                               \
  P##v = (RC)->v[lane];
#define DPPF(J, ACC, BC, SRC) asm("v_fmac_f32_dpp %0, %1, %2 row_newbcast:" #J " row_mask:0xf bank_mask:0xf" : "+v"(ACC) : "v"(BC), "v"(SRC));
#define DPPM(J, DST, BC) asm("v_mul_f32_dpp %0, %1, %0 row_newbcast:" #J " row_mask:0xf bank_mask:0xf" : "+v"(DST) : "v"(BC));
#define REP16(M, ...) M(0, __VA_ARGS__) M(1, __VA_ARGS__) M(2, __VA_ARGS__) M(3, __VA_ARGS__) M(4, __VA_ARGS__) M(5, __VA_ARGS__) \
  M(6, __VA_ARGS__) M(7, __VA_ARGS__) M(8, __VA_ARGS__) M(9, __VA_ARGS__) M(10, __VA_ARGS__) M(11, __VA_ARGS__) M(12, __VA_ARGS__) \
  M(13, __VA_ARGS__) M(14, __VA_ARGS__) M(15, __VA_ARGS__)
#define OP_SA(J, G, BC) DPPF(J, sacc[2 * G + (J & 1)], BC, S[16 * G + J])
#define OP_PRE1(J, G, BCW) DPPM(J, S[16 * G + J], BCW)
#define OP_PRE2(J, G, BCD) DPPF(J, S[16 * G + J], BCD, vv)
#define OP_POST(J, G, BCQ, BCR) DPPF(J, S[16 * G + J], BCQ, nsa) DPPF(J, yacc[2 * G + (J & 1)], BCR, S[16 * G + J])
#define SCAN_STEP(P, SIDX)                                                     \
  {                                                                            \
    const int s_ = (SIDX);                                                     \
    const int par_ = s_ & 1;                                                   \
    float sacc[4] = {0.f, 0.f, 0.f, 0.f};                                      \
    REP16(OP_SA, 0, P##kk0)                                                    \
    REP16(OP_SA, 1, P##kk1)                                                    \
    float sa_p = (sacc[0] + sacc[1]) + (sacc[2] + sacc[3]);                    \
    scan_publish(&xch[(par_ * 2 + kh) * 64 + lane], sa_p, yprev, s_ + 1);      \
    float vv = P##v;                                                           \
    REP16(OP_PRE2, 0, P##d0)                                                   \
      \
    f32x4v early_ = *(const volatile __attribute__((address_space(3))) f32x4v*)&xch[(par_ * 2 + (1 - kh)) * 64 + lane]; \
    REP16(OP_PRE2, 1, P##d1)                                                   \
    float sa_o, y_o;                                                           \
    if (__all(__float_as_int(early_.z) == s_ + 1)) { sa_o = early_.x; y_o = early_.y; }                 \
    else scan_collect(&xch[(par_ * 2 + (1 - kh)) * 64 + lane], s_ + 1, sa_o, y_o);                      \
    float nsa = -(sa_p + sa_o);                                                \
    if (kh == 0 && s_ > 0) Y[(size_t)rowprev * 512] = f2bf(yprev + y_o);                  \
    rowprev = rowcur;                                                          \
    rowcur = (s_ == 255) ? (b * TPB + 256 + (d ? 2047 : 0)) : rowcur + rstep;  \
    float yacc[4] = {0.f, 0.f, 0.f, 0.f};                                      \
    REP16(OP_POST, 0, P##q0, P##r0)                                            \
    REP16(OP_POST, 1, P##q1, P##r1)                                            \
    yprev = (yacc[0] + yacc[1]) + (yacc[2] + yacc[3]);                         \
    if ((s_ & 7) == 7) {     \
      REP16(OP_PRE1, 0, P##w0)                                                 \
      REP16(OP_PRE1, 1, P##w1)                                                 \
    }                                                                          \
  }
#pragma unroll 1
    for (int c = 0; c < 144; c++) {
      __syncthreads();
      const ScanRec* rc0 = &sm->rec[c & 1][0];
      LDSET(A, rc0)
#pragma unroll 1
      for (int i2 = 0; i2 < 8; i2++) {
        const ScanRec* rcA = rc0 + 2 * i2;
        const ScanRec* rcC = (i2 < 7) ? rcA + 2 : rcA + 1;
        LDSET(B, rcA + 1)
        SCAN_STEP(A, c * 16 + 2 * i2)
        LDSET(A, rcC)
        SCAN_STEP(B, c * 16 + 2 * i2 + 1)
      }
    }
    {
      float sa_o, y_o;
      scan_publish(&xch[(0 * 2 + kh) * 64 + lane], 0.f, yprev, 2305);
      scan_collect(&xch[(0 * 2 + (1 - kh)) * 64 + lane], 2305, sa_o, y_o);
      if (kh == 0) Y[(size_t)scan_row(b, d, 2303) * 512] = f2bf(yprev + y_o);
    }
#undef LDSET
#undef SCAN_STEP
  } else {
    PrepConst pc;
    int hc = h * 64 + lane;
    pc.cols[0] = hc; pc.cols[1] = 512 + hc; pc.cols[2] = 1024 + hc; pc.cols[3] = 1536 + d * 64 + lane; pc.cols[4] = 1664 + d * 64 + lane;
#pragma unroll
    for (int i = 0; i < 5; i++) { pc.mup[i] = p.a_mu_prev[l * 1792 + pc.cols[i]]; pc.mun[i] = p.a_mu_next[l * 1792 + pc.cols[i]]; }
    pc.w0v = p.a_w0[l * 1024 + d * 512 + hc];
    pc.a0v = p.a_a0[l * 1024 + d * 512 + hc];
    pc.kkc = p.a_k_k[l * 512 + hc];
    pc.kac = p.a_k_a[l * 512 + hc];
    pc.rkc = p.a_r_k[l * 512 + hc];
    {
      const float* wu = p.a_w_up + ((size_t)(l * 2 + d) * 64) * 512 + hc;
      const float* au = p.a_a_up + ((size_t)(l * 2 + d) * 64) * 512 + hc;
#pragma unroll
      for (int r = 0; r < 32; r++) {
        pc.wu[r] = pack2(wu[(2 * r) * 512], wu[(2 * r + 1) * 512]);
        pc.au[r] = pack2(au[(2 * r) * 512], au[(2 * r + 1) * 512]);
      }
    }
    float* stw = &sm->st[wave][0][0];
    const int base = (wave - 2) * 8;
    int i = base, c = 0;
    float Dprev = 1.f;
    PrepRaw rwA, rwB, rnA, rnB;
    prep_load(p, pc, b, d, i, rwA);
    prep_load(p, pc, b, d, i + 1, rwB);
#pragma unroll 1
    while (c < 144) {
      int i2 = i + 2, c2 = c;
      if (i2 >= base + 8) { i2 = base; c2 = c + 1; }
      if (c2 < 144) {
        prep_load(p, pc, b, d, c2 * 16 + i2, rnA);
        prep_load(p, pc, b, d, c2 * 16 + i2 + 1, rnB);
      }
      if (i == base) Dprev = 1.f;
      prep_compute2(p, pc, rwA, rwB, h, d, &sm->rec[c & 1][i], &sm->rec[c & 1][i + 1], stw, lane, Dprev);
      if (c2 != c) __syncthreads();
      rwA = rnA;
      rwB = rnB;
      i = i2;
      c = c2;
    }
  }
  __builtin_amdgcn_s_setprio(0);
}

__device__ void phase_readout(PRef p, int l) {
  int tid = tid_();
  int wave = tid >> 6, lane = tid & 63;
  int gw = bid_() * 4 + wave, nw = gridDim.x * 4;
  int h = lane >> 3, sub = lane & 7;
  int c0 = h * 64 + sub * 8;
  float mup[8], mun[8], gg[8], gb[8];
#pragma unroll
  for (int j = 0; j < 8; j++) {
    mup[j] = p.a_mu_prev[l * 1792 + 1024 + c0 + j];
    mun[j] = p.a_mu_next[l * 1792 + 1024 + c0 + j];
    gg[j] = p.a_gn_g[l * 512 + c0 + j];
    gb[j] = p.a_gn_b[l * 512 + c0 + j];
  }
  for (int R = gw; R < NROWS; R += nw) {
    int tp = R % TPB;
    if (l == 1 && tp < 256) continue;
    bool isctx = tp < 256;
    int pos = isctx ? tp : tp - 256;
    int seglen = isctx ? 256 : 2048;
    bool hp = pos > 0, hn = pos < seglen - 1;
    const bf16* z = p.ZA + (size_t)R * 1792 + 1024 + c0;
    bf16* y0p = p.HY + (size_t)R * 512 + c0;
    const bf16* y1p = p.HY + (size_t)NROWS * 512 + (size_t)R * 512 + c0;
    u32x4 a0 = *(const u32x4*)y0p, a1 = *(const u32x4*)y1p;
    u32x4 zc = *(const u32x4*)z;
    u32x4 zp = *(const u32x4*)(hp ? z - 1792 : z);
    u32x4 zn = *(const u32x4*)(hn ? z + 1792 : z);
    float bs = p.SB[(size_t)R * 16 + h] + p.SB[(size_t)R * 16 + 8 + h];
    float fp = hp ? 1.f : 0.f, fn = hn ? 1.f : 0.f;
    float y[8];
    float sum = 0.f;
#pragma unroll
    for (int j = 0; j < 4; j++) {
      y[2 * j] = bflo(a0[j]) + bflo(a1[j]);
      y[2 * j + 1] = bfhi(a0[j]) + bfhi(a1[j]);
      sum += y[2 * j] + y[2 * j + 1];
    }
    float mu = group8_sum(sum) * (1.f / 64.f);
    float sq = 0.f;
#pragma unroll
    for (int j = 0; j < 8; j++) { y[j] -= mu; sq += y[j] * y[j]; }
    float rs = rsqrtf(group8_sum(sq) * (1.f / 64.f) + 64e-5f);
    u32x4 ov;
#pragma unroll
    for (int j = 0; j < 4; j++) {
      float c_lo = bflo(zc[j]), c_hi = bfhi(zc[j]);
      float v_lo = c_lo + mup[2 * j] * (fp * bflo(zp[j]) - c_lo) + mun[2 * j] * (fn * bflo(zn[j]) - c_lo);
      float v_hi = c_hi + mup[2 * j + 1] * (fp * bfhi(zp[j]) - c_hi) + mun[2 * j + 1] * (fn * bfhi(zn[j]) - c_hi);
      float o_lo = y[2 * j] * rs * gg[2 * j] + gb[2 * j] + bs * v_lo;
      float o_hi = y[2 * j + 1] * rs * gg[2 * j + 1] + gb[2 * j + 1] + bs * v_hi;
      ov[j] = pack2(o_lo, o_hi);
    }
    *(u32x4*)y0p = ov;
  }
}

DEV bool skip_rt(int l, int rt) { return l == 1 && (rt % 18) < 2; }

__device__ void phase_gates(PRef p, int l, const bf16* H2, bf16* sA, bf16* sB) {
  const int xcd_ = bid_() & 7, per_ = gridDim.x >> 3;
  for (int t = bid_() >> 3; t < 36 * 12; t += per_) {
    int rt = xcd_ + 8 * (t / 12), ct = t % 12;
    if (skip_rt(l, rt)) continue;
    f32x16 acc[2][2];
    zero_acc<2>(acc);
    gemm_tile<2>(acc, H2 + (size_t)rt * 128 * 1024, 1024, p.WT2 + (size_t)ct * 128 * 1024, 1024, 1024, sA, sB);
    int n = ct >> 2, c0 = (ct & 3) * 128;
    bf16* dst = n == 0 ? p.HY : (n == 1 ? p.ZB : p.ZC);
    int ld = n == 2 ? 768 : 512;
    stage_tile<2>(acc, sA);
    TILE_CHUNKS(2, sA, {
      u32x4* pp = (u32x4*)(dst + (size_t)(rt * 128 + trow) * ld + c0 + tcol);
      u32x4 yv = *pp;
      u32x4 ov;
      _Pragma("unroll") for (int j = 0; j < 4; j++) {
        float g0 = __uint_as_float(cv[j] << 16), g1 = __uint_as_float(cv[j] & 0xffff0000u);
        g0 = g0 / (1.f + __expf(-g0));
        g1 = g1 / (1.f + __expf(-g1));
        float y0 = __uint_as_float(yv[j] << 16), y1 = __uint_as_float(yv[j] & 0xffff0000u);
        ov[j] = pack2(y0 * g0, y1 * g1);
      }
      *pp = ov;
    })
  }
}

__device__ void phase_merge(PRef p, int l, const bf16* H2, bf16* M, bf16* sA, bf16* sB) {
  const int xcd_ = bid_() & 7, per_ = gridDim.x >> 3;
  for (int t = bid_() >> 3; t < 36 * 8; t += per_) {
    int rt = xcd_ + 8 * (t / 8), ct = t % 8;
    if (skip_rt(l, rt)) continue;
#pragma unroll 1
    for (int n = 0; n < 3; n++) {
      const bf16* U = n == 0 ? p.HY : (n == 1 ? p.ZB : p.ZC);
      int ldu = n == 2 ? 768 : 512;
      uint32_t gp[2][2][8];
      {
        f32x16 a2[2][2];
        zero_acc<2>(a2);
        gemm_tile<2>(a2, H2 + (size_t)rt * 128 * 1024, 1024, p.WT3 + ((size_t)n * 1024 + ct * 128) * 1024, 1024, 1024, sA, sB);
#pragma unroll
        for (int a = 0; a < 2; a++)
#pragma unroll
          for (int bb = 0; bb < 2; bb++)
#pragma unroll
            for (int r = 0; r < 8; r++) {
              float g0 = __fdividef(1.f, 1.f + __expf(-a2[a][bb][2 * r]));
              float g1 = __fdividef(1.f, 1.f + __expf(-a2[a][bb][2 * r + 1]));
              gp[a][bb][r] = pack2(g0, g1);
            }
      }
      f32x16 a1[2][2];
      zero_acc<2>(a1);
      gemm_tile<2, false>(a1, U + (size_t)rt * 128 * ldu, ldu, p.WBO + ((size_t)n * 1024 + ct * 128) * 512, 512, 512, sA, sB);
#pragma unroll
      for (int a = 0; a < 2; a++)
#pragma unroll
        for (int bb = 0; bb < 2; bb++)
#pragma unroll
          for (int r = 0; r < 8; r++) {
            a1[a][bb][2 * r] *= bflo(gp[a][bb][r]);
            a1[a][bb][2 * r + 1] *= bfhi(gp[a][bb][r]);
          }
      stage_tile<2>(a1, sA);
      TILE_CHUNKS(2, sA, {
        u32x4* mp = (u32x4*)(M + (size_t)(rt * 128 + trow) * 1024 + ct * 128 + tcol);
        u32x4 ov = cv;
        if (n != 0) {
          u32x4 pv = *mp;
          _Pragma("unroll") for (int j = 0; j < 4; j++) ov[j] = pack2(bflo(pv[j]) + bflo(cv[j]), bfhi(pv[j]) + bfhi(cv[j]));
        }
        *mp = ov;
      })
    }
  }
}

__device__ void phase_out(PRef p, int l, const bf16* M, const float* xl, const float* xc, bf16* sA, bf16* sB) {
  const int xcd_ = bid_() & 7, per_ = gridDim.x >> 3;
  for (int t = bid_() >> 3; t < 36 * 8; t += per_) {
    int rt = xcd_ + 8 * (t / 8), ct = t % 8;
    if (skip_rt(l, rt)) continue;
    f32x16 acc[2][2];
    zero_acc<2>(acc);
    gemm_tile<2>(acc, M + (size_t)rt * 128 * 1024, 1024, p.WOUT + (size_t)ct * 128 * 1024, 1024, 1024, sA, sB);
    int b = rt / 18;
    bool isctx = (rt % 18) < 2;
    const float* gate = p.MOD + ((size_t)l * 17 + (isctx ? 16 : b)) * 3072 + 2048;
    stage_tile<2>(acc, sA);
    TILE_CHUNKS(2, sA, {
      int R = rt * 128 + trow;
      int col = ct * 128 + tcol;
      int tp = R % TPB;
      const float* xin;
      float* dstp;
      if (isctx) {
        xin = xc + ((size_t)b * 256 + tp) * 1024 + col;
        dstp = p.XC + ((size_t)b * 256 + tp) * 1024 + col;
      } else {
        xin = xl + ((size_t)b * 2048 + (tp - 256)) * 1024 + col;
        dstp = p.out + ((size_t)b * 2048 + (tp - 256)) * 1024 + col;
      }
      f32x4v x0 = *(const f32x4v*)xin, x1 = *(const f32x4v*)(xin + 4);
      f32x4v g0 = *(const f32x4v*)(gate + col), g1 = *(const f32x4v*)(gate + col + 4);
      f32x4v o0, o1;
      o0.x = x0.x + g0.x * __uint_as_float(cv[0] << 16);
      o0.y = x0.y + g0.y * __uint_as_float(cv[0] & 0xffff0000u);
      o0.z = x0.z + g0.z * __uint_as_float(cv[1] << 16);
      o0.w = x0.w + g0.w * __uint_as_float(cv[1] & 0xffff0000u);
      o1.x = x1.x + g1.x * __uint_as_float(cv[2] << 16);
      o1.y = x1.y + g1.y * __uint_as_float(cv[2] & 0xffff0000u);
      o1.z = x1.z + g1.z * __uint_as_float(cv[3] << 16);
      o1.w = x1.w + g1.w * __uint_as_float(cv[3] & 0xffff0000u);
      *(f32x4v*)dstp = o0;
      *(f32x4v*)(dstp + 4) = o1;
    })
  }
}

#define GB_TOP 0
#define GB_CEN(j) (64 + 32 * (j))
#define GB_CNT(j) (640 + 32 * (j))
#define GB_GEN(j) (1216 + 32 * (j))
DEV unsigned int gb_xcc() { return (unsigned int)__builtin_amdgcn_s_getreg((3 << 11) | 20) & 0xFu; }
DEV unsigned int gb_ld(unsigned int* q) { return __hip_atomic_load(q, __ATOMIC_RELAXED, __HIP_MEMORY_SCOPE_AGENT); }
DEV unsigned int gb_add(unsigned int* q) { return __hip_atomic_fetch_add(q, 1u, __ATOMIC_RELAXED, __HIP_MEMORY_SCOPE_AGENT); }
DEV void grid_barrier(unsigned int* bar, const unsigned int* sb  ) {
  __syncthreads();
  if (threadIdx.x == 0) {
    const unsigned int x = gb_xcc();
    const unsigned int nloc = sb[0], nx = sb[1];
    const unsigned int gen = gb_ld(bar + GB_GEN(x));
    const unsigned int prev = gb_add(bar + GB_CNT(x));
    if (prev == nloc - 1) {
      __hip_atomic_store(bar + GB_CNT(x), 0u, __ATOMIC_RELAXED, __HIP_MEMORY_SCOPE_AGENT);
      __builtin_amdgcn_fence(__ATOMIC_RELEASE, "agent");
      asm volatile("s_waitcnt vmcnt(0)" ::: "memory");
      const unsigned int prevt = gb_add(bar + GB_TOP);
      if (prevt == nx - 1) {
        __hip_atomic_store(bar + GB_TOP, 0u, __ATOMIC_RELAXED, __HIP_MEMORY_SCOPE_AGENT);
        for (unsigned int y = 0; y < 16; y++)
          if (gb_ld(bar + GB_CEN(y)) != 0u) (void)gb_add(bar + GB_GEN(y));
      }
    }
    while (gb_ld(bar + GB_GEN(x)) == gen) __builtin_amdgcn_s_sleep(1);
    __builtin_amdgcn_fence(__ATOMIC_ACQUIRE, "agent");
    asm volatile("s_waitcnt vmcnt(0)" ::: "memory");
  }
  __syncthreads();
}

constexpr int NSCAN = 256;
__device__ void phase_p3_mixers(PRef p, int l, unsigned char* smem, int* s_item, bf16* sA, bf16* sB, unsigned int* bar,
                                const unsigned int* sb) {
  const bool split = gridDim.x >= 2 * NSCAN;
  const bool scan_first = split && bid_() < NSCAN;
  unsigned int* flag = p.counters + 16 + l;
  if (!scan_first) {
    const int vb = split ? bid_() - NSCAN : bid_();
    const int vg = split ? (int)gridDim.x - NSCAN : (int)gridDim.x;
    unsigned int* bx = split ? bar + 2048 : bar;
    const unsigned int* sx = split ? sb + 2 : sb;
    phase_p3a(p, sA, sB, vb, vg);
    grid_barrier(bx, sx);
    phase_p3b(p, l, (float*)smem, vb, vg);
    grid_barrier(bx, sx);
    if (split && vb == 0 && threadIdx.x == 0) __hip_atomic_store(flag, 1u, __ATOMIC_RELEASE, __HIP_MEMORY_SCOPE_AGENT);
  }
  if (scan_first || !split) {
    const int cstep = split ? NSCAN : (int)gridDim.x;
    for (int chain = bid_(); chain < NSCAN; chain += cstep) scan_chain(p, l, chain, (ScanSm*)smem);
  }
  if (scan_first) {
    if (threadIdx.x == 0) {
      while (gb_ld(flag) == 0u) __builtin_amdgcn_s_sleep(2);
      __builtin_amdgcn_fence(__ATOMIC_ACQUIRE, "agent");
      asm volatile("s_waitcnt vmcnt(0)" ::: "memory");
    }
    __syncthreads();
  }
  int total = 2048 + 2048 + ((l == 0) ? 512 : 0);
  while (true) {
    __syncthreads();
    if (tid_() == 0) *s_item = (int)atomicAdd(&p.counters[l], 1u);
    __syncthreads();
    int it = *s_item;
    if (it >= total) break;
    attn_dispatch(p, l, it, (AttnSm*)smem);
  }
}

constexpr int SMEM_BYTES = 51200 + 4096;
__global__ void __launch_bounds__(256, 2) fwd_megakernel(Params p) {
  cg::grid_group grid = cg::this_grid();
  __shared__ __attribute__((aligned(16))) unsigned char smem[SMEM_BYTES];
  __shared__ int s_item;
  bf16* sA = (bf16*)smem;
  bf16* sB = (bf16*)smem + 128 * LDT;

  CParams* pk = (CParams*)__builtin_amdgcn_kernarg_segment_ptr();
  __shared__ unsigned int s_bar[4];
  if (threadIdx.x == 0) {
    (void)gb_add(pk->counters + 64 + GB_CEN(gb_xcc()));
    if (blockIdx.x >= NSCAN) (void)gb_add(pk->counters + 64 + 2048 + GB_CEN(gb_xcc()));
  }
  {
    int l0 = 0;
    asm volatile("" : "+s"(l0));
    CParams* pk0 = pk;
    asm volatile("" : "+s"(pk0));
    phase_mod(*pk0, (float*)smem);
    phase_wconv(*pk0, l0, (float*)smem);
  }
  grid.sync();
  unsigned int* bar = pk->counters + 64;
  if (threadIdx.x == 0) {
    unsigned int nloc = gb_ld(bar + GB_CEN(gb_xcc())), nx = 0;
    for (unsigned int y = 0; y < 16; y++) nx += gb_ld(bar + GB_CEN(y)) != 0u ? 1u : 0u;
    s_bar[0] = nloc;
    s_bar[1] = nx;
    unsigned int nloc2 = gb_ld(bar + 2048 + GB_CEN(gb_xcc())), nx2 = 0;
    for (unsigned int y = 0; y < 16; y++) nx2 += gb_ld(bar + 2048 + GB_CEN(y)) != 0u ? 1u : 0u;
    s_bar[2] = nloc2;
    s_bar[3] = nx2;
  }
  __syncthreads();
#pragma unroll 1
  for (int li = 0; li < 2; li++) {
    int l = li;
    asm volatile("" : "+s"(l));
    CParams* pkq = pk;
    asm volatile("" : "+s"(pkq));
    PRef q = *pkq;
    bf16* H2 = q.Q;
    bf16* M = q.ZA;
    const float* xl = l == 0 ? q.x : q.out;
    const float* xc = l == 0 ? q.ctx : q.XC;
    if (l != 0) phase_wconv(q, l, (float*)smem);
    phase_norm(q, l, xl, xc, q.HY, false);
    grid_barrier(bar, s_bar);
    phase_gemm1(q, sA, sB);
    grid_barrier(bar, s_bar);
    phase_p3_mixers(q, l, smem, &s_item, sA, sB, bar, s_bar);
    grid_barrier(bar, s_bar);
    phase_readout(q, l);
    phase_norm(q, l, xl, xc, H2, l == 1);
    grid_barrier(bar, s_bar);
    phase_gates(q, l, H2, sA, sB);
    grid_barrier(bar, s_bar);
    phase_merge(q, l, H2, M, sA, sB);
    grid_barrier(bar, s_bar);
    phase_out(q, l, M, xl, xc, sA, sB);
    grid_barrier(bar, s_bar);
  }
}

extern "C" void kernel_launch(void* const* d_in, const int* in_sizes, int n_in, void* d_out, int out_size, void* d_ws,
                              size_t ws_size, hipStream_t stream) {
  Params p;
  memset(&p, 0, sizeof(p));
  const float** pf = (const float**)&p;
  for (int i = 0; i < 30; i++) pf[i] = (const float*)d_in[i];
  p.out = (float*)d_out;
  size_t off = 0;
  auto take = [&](size_t bytes) {
    void* r = (char*)d_ws + off;
    off += (bytes + 255) & ~(size_t)255;
    return r;
  };
  p.counters = (unsigned int*)take(16384);
  p.WT1 = (bf16*)take((size_t)3072 * 1024 * 2);
  p.WT2 = (bf16*)take((size_t)1536 * 1024 * 2);
  p.WT3 = (bf16*)take((size_t)3072 * 1024 * 2);
  p.WUQ = (bf16*)take((size_t)768 * 256 * 2);
  p.WUKV = (bf16*)take((size_t)1024 * 128 * 2);
  p.WBO = (bf16*)take((size_t)3 * 1024 * 512 * 2);
  p.WOUT = (bf16*)take((size_t)1024 * 1024 * 2);
  p.MOD = (float*)take((size_t)2 * 17 * 3072 * 4);
  p.XC = (float*)take((size_t)4096 * 1024 * 4);
  p.SB = (float*)take((size_t)NROWS * 16 * 4);
  p.ROPE = (float*)take((size_t)2048 * 48 * 2 * 4);
  p.HY = (bf16*)take((size_t)NROWS * 1024 * 2);
  p.ZA = (bf16*)take((size_t)NROWS * 1792 * 2);
  p.ZB = (bf16*)take((size_t)NROWS * 512 * 2);
  p.ZC = (bf16*)take((size_t)NROWS * 768 * 2);
  p.Q = (bf16*)take((size_t)NROWS * 768 * 2);
  p.KV = (bf16*)take((size_t)NROWS * 1024 * 2);
  p.KR = (bf16*)take((size_t)NROWS * 256 * 2);
  if (off > ws_size) {
    fprintf(stderr, "workspace too small: need %zu have %zu\n", off, ws_size);
    return;
  }
  hipMemsetAsync(p.counters, 0, 16384, stream);
  static int grid_blocks = 0;
  if (!grid_blocks) {
    int dev = 0, cus = 0, per_cu = 0;
    hipGetDevice(&dev);
    hipDeviceGetAttribute(&cus, hipDeviceAttributeMultiprocessorCount, dev);
    hipOccupancyMaxActiveBlocksPerMultiprocessor(&per_cu, fwd_megakernel, 256, 0);
    if (per_cu > 2) per_cu = 2;
    grid_blocks = cus * per_cu;
  }
  void* args[] = {&p};
  hipError_t e = hipLaunchCooperativeKernel((void*)fwd_megakernel, dim3(grid_blocks), dim3(256), args, 0, stream);
  if (e != hipSuccess) fprintf(stderr, "cooperative launch failed: %s (grid %d)\n", hipGetErrorString(e), grid_blocks);
}
```

```cpp
#include <hip/hip_runtime.h>
#include <hip/hip_cooperative_groups.h>
#include <stdint.h>
#include <stdio.h>
#include <string.h>
namespace cg = cooperative_groups;

typedef unsigned short bf16;
using bf16x8 = __attribute__((ext_vector_type(8))) short;
using f32x16 = __attribute__((ext_vector_type(16))) float;
typedef float float2v __attribute__((ext_vector_type(2)));
typedef uint32_t u32x4 __attribute__((ext_vector_type(4)));
typedef unsigned int u32x2v __attribute__((ext_vector_type(2)));
typedef float f32x4v __attribute__((ext_vector_type(4)));

#define DEV __device__ __forceinline__

constexpr int NROWS = 36864;
constexpr int TPB = 2304;
constexpr int NIN = 7584;

struct Params {
  const float *x, *c, *ctx, *c_ctx, *ada_w, *ada_b, *norm_g, *w_in, *a_mu_prev, *a_mu_next, *a_w0, *a_w_up,
      *a_a0, *a_a_up, *a_k_k, *a_k_a, *a_r_k, *a_gn_g, *a_gn_b, *b_q_ln, *b_kv_ln, *b_w_uq, *b_w_ukv, *b_qn_g,
      *b_kn_g, *c_qn_g, *c_kn_g, *c_sink, *w_branch_out, *w_out;
  float* out;
  bf16 *WT1, *WT2, *WT3, *WUQ, *WUKV, *WBO, *WOUT;
  float *MOD, *XC, *SB, *ROPE;
  bf16 *HY, *ZA, *ZB, *ZC, *Q, *KV, *KR;
  unsigned int* counters;
  unsigned long long pad_;
};

typedef const Params __attribute__((address_space(4))) CParams;
typedef CParams& PRef;

typedef __bf16 hbf16x2 __attribute__((ext_vector_type(2)));
DEV bf16 f2bf(float f) {
  __bf16 h = (__bf16)f;
  return __builtin_bit_cast(bf16, h);
}
DEV uint32_t pack2(float a, float b) {
  hbf16x2 v = __builtin_convertvector(float2v{a, b}, hbf16x2);
  return __builtin_bit_cast(uint32_t, v);
}
DEV float bf2f(bf16 h) { return __uint_as_float(((uint32_t)h) << 16); }
template <int CTRL>
DEV float dpp_mov(float v) {
  return __int_as_float(__builtin_amdgcn_update_dpp(0, __float_as_int(v), CTRL, 0xf, 0xf, true));
}
DEV float wave_sum(float v) {
  v += dpp_mov<0xB1>(v);
  v += dpp_mov<0x4E>(v);
  v += dpp_mov<0x141>(v);
  v += dpp_mov<0x140>(v);
  int vi = __float_as_int(v);
  float r0 = __int_as_float(__builtin_amdgcn_readlane(vi, 0));
  float r1 = __int_as_float(__builtin_amdgcn_readlane(vi, 16));
  float r2 = __int_as_float(__builtin_amdgcn_readlane(vi, 32));
  float r3 = __int_as_float(__builtin_amdgcn_readlane(vi, 48));
  return (r0 + r1) + (r2 + r3);
}
DEV void wbar() { __builtin_amdgcn_wave_barrier(); }
DEV void lds_barrier() { asm volatile("s_waitcnt lgkmcnt(0)\n\ts_barrier" ::: "memory"); }
DEV const float* xrow_ptr(const float* xl, const float* xc, int R) {
  int b = R / TPB, tp = R % TPB;
  return tp < 256 ? xc + ((size_t)b * 256 + tp) * 1024 : xl + ((size_t)b * 2048 + (tp - 256)) * 1024;
}

DEV int tid_() { int t = threadIdx.x; asm volatile("" : "+v"(t)); return t; }
DEV int bid_() { int b = blockIdx.x; asm volatile("" : "+s"(b)); return b; }

__device__ void phase_mod(PRef p, float* smem) {
  float* sc = smem;
  float* red = smem + 17 * 256;
  int tid = tid_();
  int kg = tid >> 5, col = tid & 31;
  for (int e = bid_() * 256 + tid; e < 2048 * 48; e += gridDim.x * 256) {
    int t = e / 48, j = e % 48;
    int half_axis, idx;
    if (j < 16) { half_axis = 16; idx = j; } else { half_axis = 32; idx = j - 16; }
    int qd = half_axis / 2;
    int axis = idx / qd, i = idx % qd;
    float inv = powf(10000.f, -(2.f * (float)i) / (float)half_axis);
    float ang = (axis ? (float)(t & 63) : (float)(t >> 6)) * inv;
    float sn, cs;
    sincosf(ang, &sn, &cs);
    p.ROPE[(size_t)e * 2] = cs;
    p.ROPE[(size_t)e * 2 + 1] = sn;
  }
  float* sc2 = smem;
  float* red2 = smem + 17 * 256;
  int kg2 = tid >> 4, col2 = tid & 15;
  for (int u = bid_(); u < 384; u += gridDim.x) {
    int l = u / 192, n0 = (u % 192) * 16;
    float acc[17];
#pragma unroll
    for (int i = 0; i < 17; i++) acc[i] = 0.f;
    for (int kc = 0; kc < 4; kc++) {
      __syncthreads();
      for (int e = tid; e < 17 * 256; e += 256) {
        int bi = e >> 8, k = e & 255;
        float cv = bi < 16 ? p.c[bi * 1024 + kc * 256 + k] : p.c_ctx[kc * 256 + k];
        sc2[e] = cv / (1.f + expf(-cv));
      }
      __syncthreads();
#pragma unroll 4
      for (int kk = 0; kk < 16; kk++) {
        int k = kg2 * 16 + kk;
        float w = p.ada_w[((size_t)l * 1024 + kc * 256 + k) * 3072 + n0 + col2];
#pragma unroll
        for (int bi = 0; bi < 17; bi++) acc[bi] += sc2[bi * 256 + k] * w;
      }
    }
    __syncthreads();
#pragma unroll
    for (int bi = 0; bi < 17; bi++) red2[(kg2 * 17 + bi) * 16 + col2] = acc[bi];
    __syncthreads();
    for (int e = tid; e < 17 * 16; e += 256) {
      int bi = e >> 4, cc = e & 15;
      float sacc = 0.f;
      for (int gq = 0; gq < 16; gq++) sacc += red2[(gq * 17 + bi) * 16 + cc];
      p.MOD[((size_t)l * 17 + bi) * 3072 + n0 + cc] = sacc + p.ada_b[l * 3072 + n0 + cc];
    }
    __syncthreads();
  }
}

struct Job {
  const float* src;
  const float* rs;
  bf16* dst;
  int sld, K, nvalid, npad;
};
DEV Job get_job(PRef p, int l, int j) {
  const float* win = p.w_in + (size_t)l * 1024 * NIN;
  Job jb;
  jb.rs = nullptr;
  jb.sld = NIN;
  jb.K = 1024;
  switch (j) {
    case 0: jb.src = win; jb.dst = p.WT1; jb.nvalid = 1792; jb.npad = 1792; break;
    case 1: jb.src = win + 2304; jb.dst = p.WT1 + (size_t)1792 * 1024; jb.nvalid = 416; jb.npad = 512; break;
    case 2: jb.src = win + 3232; jb.dst = p.WT1 + (size_t)2304 * 1024; jb.nvalid = 768; jb.npad = 768; break;
    case 3: jb.src = win + 1792; jb.dst = p.WT2; jb.nvalid = 512; jb.npad = 512; break;
    case 4: jb.src = win + 2720; jb.dst = p.WT2 + (size_t)512 * 1024; jb.nvalid = 512; jb.npad = 512; break;
    case 5: jb.src = win + 4000; jb.dst = p.WT2 + (size_t)1024 * 1024; jb.nvalid = 512; jb.npad = 512; break;
    case 6: jb.src = win + 4512; jb.dst = p.WT3; jb.nvalid = 3072; jb.npad = 3072; break;
    case 7:
      jb.src = p.b_w_uq + (size_t)l * 256 * 768; jb.rs = p.b_q_ln + l * 256; jb.dst = p.WUQ; jb.sld = 768; jb.K = 256;
      jb.nvalid = 768; jb.npad = 768; break;
    case 8:
      jb.src = p.b_w_ukv + (size_t)l * 128 * 1024; jb.rs = p.b_kv_ln + l * 128; jb.dst = p.WUKV; jb.sld = 1024;
      jb.K = 128; jb.nvalid = 1024; jb.npad = 1024; break;
    case 9: case 10: case 11:
      jb.src = p.w_branch_out + ((size_t)l * 3 + (j - 9)) * 512 * 1024; jb.dst = p.WBO + (size_t)(j - 9) * 1024 * 512;
      jb.sld = 1024; jb.K = 512; jb.nvalid = 1024; jb.npad = 1024; break;
    default:
      jb.src = p.w_out + (size_t)l * 1024 * 1024; jb.dst = p.WOUT; jb.sld = 1024; jb.K = 1024; jb.nvalid = 1024;
      jb.npad = 1024; break;
  }
  return jb;
}
__device__ void phase_wconv(PRef p, int l, float* sm) {
  int tid = tid_();
  int g0 = 0;
  for (int j = 0; j < 13; j++) {
    int jq = j;
    asm volatile("" : "+s"(jq));
    Job jb = get_job(p, l, jq);
    int nn = jb.npad / 64;
    int nt_total = (jb.K / 64) * nn;
    int first = (bid_() - (g0 % (int)gridDim.x) + (int)gridDim.x) % (int)gridDim.x;
    for (int t = first; t < nt_total; t += gridDim.x) {
      int kt = t / nn, nt = t % nn;
      __syncthreads();
      for (int e = tid; e < 4096; e += 256) {
        int i = e >> 6, jj = e & 63;
        int k = kt * 64 + i, n = nt * 64 + jj;
        float v = (n < jb.nvalid) ? jb.src[(size_t)k * jb.sld + n] : 0.f;
        if (jb.rs) v *= jb.rs[k];
        sm[i * 65 + jj] = v;
      }
      __syncthreads();
      for (int e = tid; e < 4096; e += 256) {
        int jj = e >> 6, i = e & 63;
        jb.dst[(size_t)(nt * 64 + jj) * jb.K + kt * 64 + i] = f2bf(sm[i * 65 + jj]);
      }
    }
    g0 += nt_total;
  }
}

__device__ void phase_norm(PRef p, int l, const float* xl, const float* xc, bf16* H, bool skip_ctx) {
  int tid = tid_();
  int wave = tid >> 6, lane = tid & 63;
  int gw = bid_() * 4 + wave, nw = gridDim.x * 4;
  const float* g = p.norm_g + l * 1024;
  for (int R0 = gw; R0 < NROWS; R0 += 2 * nw) {
    f32x4v v[2][4];
    bool ok[2];
    int Rr[2];
#pragma unroll
    for (int u = 0; u < 2; u++) {
      int R = R0 + u * nw;
      Rr[u] = R;
      ok[u] = R < NROWS && !(skip_ctx && (R % TPB) < 256);
      if (ok[u]) {
        const float* xr = xrow_ptr(xl, xc, R);
#pragma unroll
        for (int i = 0; i < 4; i++) v[u][i] = *(const f32x4v*)(xr + i * 256 + lane * 4);
      } else {
#pragma unroll
        for (int i = 0; i < 4; i++) v[u][i] = f32x4v{0.f, 0.f, 0.f, 0.f};
      }
    }
#pragma unroll
    for (int u = 0; u < 2; u++) {
      float ss = 0.f;
#pragma unroll
      for (int i = 0; i < 4; i++) ss += v[u][i].x * v[u][i].x + v[u][i].y * v[u][i].y + v[u][i].z * v[u][i].z + v[u][i].w * v[u][i].w;
      ss = wave_sum(ss);
      if (!ok[u]) continue;
      int R = Rr[u];
      int b = R / TPB, tp = R % TPB;
      int mi = tp < 256 ? 16 : b;
      const float* md = p.MOD + ((size_t)l * 17 + mi) * 3072;
      float rstd = rsqrtf(ss * (1.f / 1024.f) + 1e-6f);
#pragma unroll
      for (int i = 0; i < 4; i++) {
        int col = i * 256 + lane * 4;
        f32x4v gg = *(const f32x4v*)(g + col);
        f32x4v sh = *(const f32x4v*)(md + col);
        f32x4v sc = *(const f32x4v*)(md + 1024 + col);
        float h0 = v[u][i].x * rstd * gg.x * (1.f + sc.x) + sh.x;
        float h1 = v[u][i].y * rstd * gg.y * (1.f + sc.y) + sh.y;
        float h2 = v[u][i].z * rstd * gg.z * (1.f + sc.z) + sh.z;
        float h3 = v[u][i].w * rstd * gg.w * (1.f + sc.w) + sh.w;
        uint2 o;
        o.x = pack2(h0, h1);
        o.y = pack2(h2, h3);
        *(uint2*)(H + (size_t)R * 1024 + col) = o;
      }
    }
  }
}

constexpr int LDT = 72;
template <int NI>
DEV void zero_acc(f32x16 (&acc)[2][NI]) {
#pragma unroll
  for (int a = 0; a < 2; a++)
#pragma unroll
    for (int b = 0; b < NI; b++)
#pragma unroll
      for (int r = 0; r < 16; r++) acc[a][b][r] = 0.f;
}
template <int NI, bool DEEP = true>
DEV void gemm_tile(f32x16 (&acc)[2][NI], const bf16* __restrict__ A, int lda, const bf16* __restrict__ Bt, int ldb,
                   int K, bf16* sA, bf16* sB) {
  int tid = tid_(), lane = tid & 63, wave = tid >> 6;
  int wm = wave >> 1, wn = wave & 1;
  int lr = tid >> 3, lc = (tid & 7) * 8;
  const bf16* Ap = A + (size_t)lr * lda + lc;
  const bf16* Bp = Bt + (size_t)lr * ldb + lc;
  u32x4 ra0[4], rb0[2 * NI], ra1[4], rb1[2 * NI];
#define G_LOAD(RA, RB, KOFF)                                                              \
  {                                                                                       \
    _Pragma("unroll") for (int i = 0; i < 4; i++) RA[i] = *(const u32x4*)(Ap + (size_t)(32 * i) * lda + (KOFF));      \
    _Pragma("unroll") for (int i = 0; i < 2 * NI; i++) RB[i] = *(const u32x4*)(Bp + (size_t)(32 * i) * ldb + (KOFF)); \
  }
#define G_STEP(RA, RB, KNEXT)                                                             \
  {                                                                                       \
    lds_barrier();                                                                        \
    _Pragma("unroll") for (int i = 0; i < 4; i++) *(u32x4*)(sA + (lr + 32 * i) * LDT + lc) = RA[i];      \
    _Pragma("unroll") for (int i = 0; i < 2 * NI; i++) *(u32x4*)(sB + (lr + 32 * i) * LDT + lc) = RB[i]; \
    lds_barrier();                                                                        \
    if ((KNEXT) < K) G_LOAD(RA, RB, KNEXT)                                                \
    _Pragma("unroll") for (int ks = 0; ks < 4; ks++) {                                    \
      bf16x8 af[2], bfr[NI];                                                              \
      _Pragma("unroll") for (int mi = 0; mi < 2; mi++)                                    \
        af[mi] = *(const bf16x8*)(sA + (wm * 64 + mi * 32 + (lane & 31)) * LDT + ks * 16 + (lane >> 5) * 8);          \
      _Pragma("unroll") for (int ni = 0; ni < NI; ni++)                                   \
        bfr[ni] = *(const bf16x8*)(sB + (wn * NI * 32 + ni * 32 + (lane & 31)) * LDT + ks * 16 + (lane >> 5) * 8);    \
      _Pragma("unroll") for (int mi = 0; mi < 2; mi++)                                    \
        _Pragma("unroll") for (int ni = 0; ni < NI; ni++)                                 \
          acc[mi][ni] = __builtin_amdgcn_mfma_f32_32x32x16_bf16(bfr[ni], af[mi], acc[mi][ni], 0, 0, 0);                \
    }                                                                                     \
      \
    if (DEEP) {                                                                           \
    __builtin_amdgcn_sched_group_barrier(0x100, 2 + NI, 0);                               \
    __builtin_amdgcn_sched_group_barrier(0x008, 1, 0);                                    \
    __builtin_amdgcn_sched_group_barrier(0x100, NI == 1 ? 2 : 1, 0);                      \
    _Pragma("unroll") for (int q_ = 0; q_ < (NI == 1 ? 7 : 11); q_++) {                   \
      __builtin_amdgcn_sched_group_barrier(0x008, 1, 0);                                  \
      __builtin_amdgcn_sched_group_barrier(0x100, 1, 0);                                  \
    }                                                                                     \
    __builtin_amdgcn_sched_group_barrier(0x008, NI == 1 ? 0 : 4, 0);                      \
    }                                                                                     \
  }
  G_LOAD(ra0, rb0, 0)
  if (DEEP) {
    if (64 < K) G_LOAD(ra1, rb1, 64)
    for (int k0 = 0; k0 < K; k0 += 128) {
      G_STEP(ra0, rb0, k0 + 128)
      if (k0 + 64 < K) G_STEP(ra1, rb1, k0 + 192)
    }
  } else {
    for (int k0 = 0; k0 < K; k0 += 64) G_STEP(ra0, rb0, k0 + 64)
  }
#undef G_LOAD
#undef G_STEP
}
template <int NI>
DEV void stage_tile(const f32x16 (&acc)[2][NI], bf16* sC) {
  constexpr int LDC = NI * 64 + 8;
  int tid = tid_();
  int lane = tid & 63, wave = tid >> 6;
  int wm = wave >> 1, wn = wave & 1;
  __syncthreads();
#pragma unroll
  for (int mi = 0; mi < 2; mi++)
#pragma unroll
    for (int ni = 0; ni < NI; ni++)
#pragma unroll
      for (int g = 0; g < 4; g++) {
        int row = wm * 64 + mi * 32 + (lane & 31);
        int col = wn * NI * 32 + ni * 32 + 8 * g + 4 * (lane >> 5);
        uint2 v;
        v.x = pack2(acc[mi][ni][4 * g], acc[mi][ni][4 * g + 1]);
        v.y = pack2(acc[mi][ni][4 * g + 2], acc[mi][ni][4 * g + 3]);
        *(uint2*)(sC + row * LDC + col) = v;
      }
  __syncthreads();
}
#define TILE_CHUNKS(NI_, sC_, ...)                                            \
  {                                                                           \
    constexpr int LDC_ = NI_ * 64 + 8;                                        \
    int tid__ = tid_();                                                       \
    _Pragma("unroll") for (int it_ = 0; it_ < NI_ * 4; it_++) {               \
      int c_ = tid__ + it_ * 256;                                             \
      int trow = c_ / (NI_ * 8), tcol = (c_ % (NI_ * 8)) * 8;                 \
      u32x4 cv = *(const u32x4*)(sC_ + trow * LDC_ + tcol);                   \
      __VA_ARGS__                                                             \
    }                                                                         \
  }

__device__ void phase_gemm1(PRef p, bf16* sA, bf16* sB) {
  const int xcd_ = bid_() & 7, per_ = gridDim.x >> 3;
  for (int t = bid_() >> 3; t < 36 * 24; t += per_) {
    int rt = xcd_ + 8 * (t / 24), ct = t % 24;
    f32x16 acc[2][2];
    zero_acc<2>(acc);
    gemm_tile<2>(acc, p.HY + (size_t)rt * 128 * 1024, 1024, p.WT1 + (size_t)ct * 128 * 1024, 1024, 1024, sA, sB);
    bf16* dst;
    int ld, c0;
    if (ct < 14) { dst = p.ZA; ld = 1792; c0 = ct * 128; }
    else if (ct < 18) { dst = p.ZB; ld = 512; c0 = (ct - 14) * 128; }
    else { dst = p.ZC; ld = 768; c0 = (ct - 18) * 128; }
    stage_tile<2>(acc, sA);
    TILE_CHUNKS(2, sA, { *(u32x4*)(dst + (size_t)(rt * 128 + trow) * ld + c0 + tcol) = cv; })
  }
}

__device__ void phase_p3a(PRef p, bf16* sA, bf16* sB, int vb, int vg) {
  const int xcd_ = vb & 7, per_ = vg >> 3;
  for (int t = vb >> 3; t < 36 * 14; t += per_) {
    int rt = xcd_ + 8 * (t / 14), ct = t % 14;
    f32x16 acc[2][2];
    zero_acc<2>(acc);
    if (ct < 6) {
      gemm_tile<2>(acc, p.ZB + (size_t)rt * 128 * 512, 512, p.WUQ + (size_t)ct * 128 * 256, 256, 256, sA, sB);
      stage_tile<2>(acc, sA);
      TILE_CHUNKS(2, sA, { *(u32x4*)(p.Q + (size_t)(rt * 128 + trow) * 768 + ct * 128 + tcol) = cv; })
    } else {
      int c2 = ct - 6;
      gemm_tile<2>(acc, p.ZB + (size_t)rt * 128 * 512 + 256, 512, p.WUKV + (size_t)c2 * 128 * 128, 128, 128, sA, sB);
      stage_tile<2>(acc, sA);
      TILE_CHUNKS(2, sA, { *(u32x4*)(p.KV + (size_t)(rt * 128 + trow) * 1024 + c2 * 128 + tcol) = cv; })
    }
  }
}

DEV float group8_sum(float v) {
  v += dpp_mov<0xB1>(v);
  v += dpp_mov<0x4E>(v);
  v += dpp_mov<0x141>(v);
  return v;
}
DEV float lane_xor2(float v) { return dpp_mov<0x4E>(v); }
DEV float bflo(uint32_t u) { return __uint_as_float(u << 16); }
DEV float bfhi(uint32_t u) { return __uint_as_float(u & 0xffff0000u); }
__device__ void phase_p3b(PRef p, int l, float* smem, int vb, int vg) {
  (void)smem;
  int tid = tid_();
  int wave = tid >> 6, lane = tid & 63;
  int gw = vb * 4 + wave, nw = vg * 4;
  int h = lane >> 3, sub = lane & 7;
  int hfB = (sub >> 1) & 1;
  const float* qn_g = p.b_qn_g + l * 96;
  const float* kn_g = p.b_kn_g + l * 96;
  const float* cq_g = p.c_qn_g + l * 64;
  const float* ck_g = p.c_kn_g + l * 64;
  float gqN[8], gqR[4], gkN[16], gkR[4], gkRp[4], gcq[8], gck[8];
#pragma unroll
  for (int j = 0; j < 8; j++) { gqN[j] = qn_g[sub * 8 + j]; gcq[j] = cq_g[sub * 8 + j]; gck[j] = ck_g[sub * 8 + j]; }
#pragma unroll
  for (int j = 0; j < 4; j++) {
    gqR[j] = qn_g[64 + sub * 4 + j];
    gkR[j] = kn_g[64 + sub * 4 + j];
    gkRp[j] = kn_g[64 + ((sub ^ 2) * 4) + j];
  }
#pragma unroll
  for (int j = 0; j < 16; j++) gkN[j] = kn_g[(sub & 3) * 16 + j];
  for (int R = gw; R < NROWS; R += nw) {
    int tp = R % TPB;
    bool lat = tp >= 256;
    int t = lat ? tp - 256 : 0;
    const bf16* zb = p.ZB + (size_t)R * 512;
    bf16* q = p.Q + (size_t)R * 768;
    bf16* kv = p.KV + (size_t)R * 1024;
    bf16* kr = p.KR + (size_t)R * 256;
    bf16* zc = p.ZC + (size_t)R * 768;
    const float* tabB = p.ROPE + (size_t)t * 96;
    const float* tabC = tabB + 32;
    uint2 cq2 = *(const uint2*)(zb + lane * 4);
    uint32_t ckv2 = *(const uint32_t*)(zb + 256 + lane * 2);
    uint2 krO = *(const uint2*)(zb + 384 + sub * 4);
    uint2 krP = *(const uint2*)(zb + 384 + (sub ^ 2) * 4);
    u32x4 qN = *(const u32x4*)(q + h * 96 + sub * 8);
    uint2 qR = *(const uint2*)(q + h * 96 + 64 + sub * 4);
    u32x4 kv0 = *(const u32x4*)(kv + h * 128 + sub * 16);
    u32x4 kv1 = *(const u32x4*)(kv + h * 128 + sub * 16 + 8);
    u32x4 cqv = *(const u32x4*)(zc + h * 64 + sub * 8);
    u32x4 ckv = *(const u32x4*)(zc + 512 + (h & 1) * 64 + sub * 8);
    int axis = sub >> 2;
    f32x4v tB0 = *(const f32x4v*)(tabB + 2 * (axis * 8 + (sub & 1) * 4));
    f32x4v tB1 = *(const f32x4v*)(tabB + 2 * (axis * 8 + (sub & 1) * 4) + 4);
    f32x4v tC[4];
#pragma unroll
    for (int i = 0; i < 4; i++) tC[i] = *(const f32x4v*)(tabC + 2 * (axis * 16 + (sub & 1) * 8) + 4 * i);
    float ss = bflo(cq2.x) * bflo(cq2.x) + bfhi(cq2.x) * bfhi(cq2.x) + bflo(cq2.y) * bflo(cq2.y) + bfhi(cq2.y) * bfhi(cq2.y);
    float rq = rsqrtf(wave_sum(ss) * (1.f / 256.f) + 1e-6f);
    ss = bflo(ckv2) * bflo(ckv2) + bfhi(ckv2) * bfhi(ckv2);
    float rkv = rsqrtf(wave_sum(ss) * (1.f / 128.f) + 1e-6f);
    float krv[4] = {bflo(krO.x), bfhi(krO.x), bflo(krO.y), bfhi(krO.y)};
    float krp[4] = {bflo(krP.x), bfhi(krP.x), bflo(krP.y), bfhi(krP.y)};
    float sskr = group8_sum(krv[0] * krv[0] + krv[1] * krv[1] + krv[2] * krv[2] + krv[3] * krv[3]);
    float csB[4] = {tB0.x, tB0.z, tB1.x, tB1.z}, snB[4] = {tB0.y, tB0.w, tB1.y, tB1.w};
    {
      float vN[8], vR[4];
#pragma unroll
      for (int j = 0; j < 4; j++) { vN[2 * j] = bflo(qN[j]) * rq; vN[2 * j + 1] = bfhi(qN[j]) * rq; }
      vR[0] = bflo(qR.x) * rq; vR[1] = bfhi(qR.x) * rq; vR[2] = bflo(qR.y) * rq; vR[3] = bfhi(qR.y) * rq;
      float s2 = 0.f;
#pragma unroll
      for (int j = 0; j < 8; j++) s2 += vN[j] * vN[j];
#pragma unroll
      for (int j = 0; j < 4; j++) s2 += vR[j] * vR[j];
      float r = rsqrtf(group8_sum(s2) * (1.f / 96.f) + 1e-6f);
      u32x4 oN;
#pragma unroll
      for (int j = 0; j < 4; j++) oN[j] = pack2(vN[2 * j] * r * gqN[2 * j], vN[2 * j + 1] * r * gqN[2 * j + 1]);
      float oR[4];
#pragma unroll
      for (int j = 0; j < 4; j++) {
        float own = vR[j] * r * gqR[j];
        float par = lane_xor2(own);
        float x1 = hfB ? par : own, x2 = hfB ? own : par;
        float ro = hfB ? x1 * snB[j] + x2 * csB[j] : x1 * csB[j] - x2 * snB[j];
        oR[j] = lat ? ro : own;
      }
      *(u32x4*)(q + h * 96 + sub * 8) = oN;
      *(uint2*)(q + h * 96 + 64 + sub * 4) = make_uint2(pack2(oR[0], oR[1]), pack2(oR[2], oR[3]));
    }
    {
      float e16[16];
#pragma unroll
      for (int j = 0; j < 4; j++) {
        e16[2 * j] = bflo(kv0[j]) * rkv; e16[2 * j + 1] = bfhi(kv0[j]) * rkv;
        e16[8 + 2 * j] = bflo(kv1[j]) * rkv; e16[8 + 2 * j + 1] = bfhi(kv1[j]) * rkv;
      }
      float s2 = 0.f;
#pragma unroll
      for (int j = 0; j < 16; j++) s2 += e16[j] * e16[j];
      if (sub >= 4) s2 = 0.f;
      float rk = rsqrtf((group8_sum(s2) + sskr) * (1.f / 96.f) + 1e-6f);
      u32x4 o0, o1;
#pragma unroll
      for (int j = 0; j < 4; j++) {
        float a0 = e16[2 * j], a1 = e16[2 * j + 1], b0 = e16[8 + 2 * j], b1 = e16[8 + 2 * j + 1];
        if (sub < 4) {
          a0 *= rk * gkN[2 * j]; a1 *= rk * gkN[2 * j + 1];
          b0 *= rk * gkN[8 + 2 * j]; b1 *= rk * gkN[8 + 2 * j + 1];
        }
        o0[j] = pack2(a0, a1);
        o1[j] = pack2(b0, b1);
      }
      *(u32x4*)(kv + h * 128 + sub * 16) = o0;
      *(u32x4*)(kv + h * 128 + sub * 16 + 8) = o1;
      float oR[4];
#pragma unroll
      for (int j = 0; j < 4; j++) {
        float own = krv[j] * rk * gkR[j];
        float par = krp[j] * rk * gkRp[j];
        float x1 = hfB ? par : own, x2 = hfB ? own : par;
        float ro = hfB ? x1 * snB[j] + x2 * csB[j] : x1 * csB[j] - x2 * snB[j];
        oR[j] = lat ? ro : own;
      }
      *(uint2*)(kr + h * 32 + sub * 4) = make_uint2(pack2(oR[0], oR[1]), pack2(oR[2], oR[3]));
    }
    {
      float csC[8], snC[8];
#pragma unroll
      for (int i = 0; i < 4; i++) { csC[2 * i] = tC[i].x; snC[2 * i] = tC[i].y; csC[2 * i + 1] = tC[i].z; snC[2 * i + 1] = tC[i].w; }
#pragma unroll
      for (int pass = 0; pass < 2; pass++) {
        u32x4 raw = pass == 0 ? cqv : ckv;
        float v8[8];
#pragma unroll
        for (int j = 0; j < 4; j++) { v8[2 * j] = bflo(raw[j]); v8[2 * j + 1] = bfhi(raw[j]); }
        float s2 = 0.f;
#pragma unroll
        for (int j = 0; j < 8; j++) s2 += v8[j] * v8[j];
        float r = rsqrtf(group8_sum(s2) * (1.f / 64.f) + 1e-6f);
        float o8[8];
#pragma unroll
        for (int j = 0; j < 8; j++) {
          float own = v8[j] * r * (pass == 0 ? gcq[j] : gck[j]);
          float par = lane_xor2(own);
          float x1 = hfB ? par : own, x2 = hfB ? own : par;
          float ro = hfB ? x1 * snC[j] + x2 * csC[j] : x1 * csC[j] - x2 * snC[j];
          o8[j] = lat ? ro : own;
        }
        u32x4 ov;
#pragma unroll
        for (int j = 0; j < 4; j++) ov[j] = pack2(o8[2 * j], o8[2 * j + 1]);
        if (pass == 0) *(u32x4*)(zc + h * 64 + sub * 8) = ov;
        else if (lane < 16) *(u32x4*)(zc + 512 + h * 64 + sub * 8) = ov;
      }
    }
  }
}

typedef short s16x4 __attribute__((ext_vector_type(4)));
struct AttnSm {
  bf16 K[128 * 104];
  bf16 V[128 * 96];
};
template <int DQK>
__device__ void attn_item(const bf16* Qp, int ldq, const bf16* K1, int ldk1, const bf16* K2, int ldk2, const bf16* V,
                          int ldv, int seg0_row, int seg0_tiles, int seg1_row, int seg1_tiles, int qrow0, bool masked0,
                          float scale, bool has_sink, float sink, bf16* O, int ldo, AttnSm* sm) {
  constexpr int NKS = DQK / 16;
  constexpr int CPK = DQK / 8;
  int tid = tid_(), lane = tid & 63, wave = tid >> 6;
  int hh = lane >> 5;
  int qi = wave * 32 + (lane & 31);
  int qrow = qrow0 + qi;
  bf16x8 qf[NKS];
#pragma unroll
  for (int ks = 0; ks < NKS; ks++) qf[ks] = *(const bf16x8*)(Qp + (size_t)qi * ldq + ks * 16 + hh * 8);
  f32x16 o[2];
#pragma unroll
  for (int db = 0; db < 2; db++)
#pragma unroll
    for (int r = 0; r < 16; r++) o[db][r] = 0.f;
  const float scale2 = scale * 1.4426950408889634f;
  float m = has_sink ? sink * 1.4426950408889634f : -1e30f;
  float lsum = has_sink ? 1.f : 0.f;
  seg0_tiles >>= 1;
  seg1_tiles >>= 1;
  int ntiles = seg0_tiles + seg1_tiles;
  constexpr int KCH = (128 * CPK) / 256;
  u32x4 kreg[KCH], vreg[4];
  auto issue_loads = [&](int tt) {
    int krow0 = tt < seg0_tiles ? seg0_row + tt * 128 : seg1_row + (tt - seg0_tiles) * 128;
#pragma unroll
    for (int it = 0; it < KCH; it++) {
      int c = tid + it * 256;
      int key = c / CPK, ch = c % CPK;
      const bf16* src = ch < 8 ? K1 + (size_t)(krow0 + key) * ldk1 + ch * 8 : K2 + (size_t)(krow0 + key) * ldk2 + (ch - 8) * 8;
      kreg[it] = *(const u32x4*)src;
    }
#pragma unroll
    for (int it = 0; it < 4; it++) {
      int c = tid + it * 256;
      int key = c >> 3, ch = c & 7;
      vreg[it] = *(const u32x4*)(V + (size_t)(krow0 + key) * ldv + ch * 8);
    }
  };
  issue_loads(0);
  for (int tt = 0; tt < ntiles; tt++) {
    int krow0 = tt < seg0_tiles ? seg0_row + tt * 128 : seg1_row + (tt - seg0_tiles) * 128;
    bool msk = masked0 && tt < seg0_tiles;
    lds_barrier();
#pragma unroll
    for (int it = 0; it < KCH; it++) {
      int c = tid + it * 256;
      int key = c / CPK, ch = c % CPK;
      *(u32x4*)(sm->K + key * 104 + ch * 8) = kreg[it];
    }
#pragma unroll
    for (int it = 0; it < 4; it++) {
      int c = tid + it * 256;
      int key = c >> 3, ch = c & 7;
      *(u32x4*)(sm->V + key * 96 + ch * 8) = vreg[it];
    }
    lds_barrier();
    if (tt + 1 < ntiles) issue_loads(tt + 1);
    const int qlo_ = qrow0 + wave * 32;
    bool skipkb[4];
#pragma unroll
    for (int kb = 0; kb < 4; kb++) {
      int klo_ = krow0 + kb * 32;
      skipkb[kb] = msk && ((klo_ - (qlo_ + 31) > 128) || (qlo_ - (klo_ + 31) > 128));
    }
    f32x16 s[4];
#pragma unroll
    for (int kb = 0; kb < 4; kb++) {
#pragma unroll
      for (int r = 0; r < 16; r++) s[kb][r] = 0.f;
      if (skipkb[kb]) continue;
#pragma unroll
      for (int ks = 0; ks < NKS; ks++) {
        bf16x8 a = *(const bf16x8*)(sm->K + (kb * 32 + (lane & 31)) * 104 + ks * 16 + hh * 8);
        s[kb] = __builtin_amdgcn_mfma_f32_32x32x16_bf16(a, qf[ks], s[kb], 0, 0, 0);
      }
    }
    float mx = -1e30f;
#pragma unroll
    for (int kb = 0; kb < 4; kb++)
#pragma unroll
      for (int r = 0; r < 16; r++) {
        float v = s[kb][r];
        if (msk) {
          int key = kb * 32 + (r & 3) + 8 * (r >> 2) + 4 * hh;
          int d = (krow0 + key) - qrow;
          if (d > 128 || d < -128) v = -1e30f;
          s[kb][r] = v;
        }
        mx = fmaxf(mx, v);
      }
    {
      u32x2v r2 = __builtin_amdgcn_permlane32_swap(__float_as_uint(mx), __float_as_uint(mx), false, false);
      mx = fmaxf(__uint_as_float(r2[0]), __uint_as_float(r2[1]));
    }
    float m_new = fmaxf(m, mx * scale2);
    float alpha = __builtin_amdgcn_exp2f(m - m_new);
    float psum = 0.f;
#pragma unroll
    for (int kb = 0; kb < 4; kb++)
#pragma unroll
      for (int r = 0; r < 16; r++) {
        float pv = skipkb[kb] ? 0.f : __builtin_amdgcn_exp2f(__builtin_fmaf(s[kb][r], scale2, -m_new));
        s[kb][r] = pv;
        psum += pv;
      }
    {
      u32x2v r2 = __builtin_amdgcn_permlane32_swap(__float_as_uint(psum), __float_as_uint(psum), false, false);
      psum = __uint_as_float(r2[0]) + __uint_as_float(r2[1]);
    }
    lsum = lsum * alpha + psum;
    if (!__all(m_new == m)) {
#pragma unroll
      for (int db = 0; db < 2; db++)
#pragma unroll
        for (int r = 0; r < 16; r++) o[db][r] *= alpha;
    }
    m = m_new;
#pragma unroll
    for (int kb = 0; kb < 4; kb++)
#pragma unroll
      for (int s2 = 0; s2 < 2; s2++) {
        if (skipkb[kb]) continue;
        u32x4 pfu;
#pragma unroll
        for (int j = 0; j < 4; j++) pfu[j] = pack2(s[kb][8 * s2 + 2 * j], s[kb][8 * s2 + 2 * j + 1]);
        bf16x8 pf = __builtin_bit_cast(bf16x8, pfu);
#pragma unroll
        for (int db = 0; db < 2; db++) {
          typedef __attribute__((address_space(3))) s16x4* lds_s4p;
          const bf16* vb = sm->V + (kb * 32 + 16 * s2 + 4 * hh + ((lane & 15) >> 2)) * 96 + db * 32 + 16 * ((lane >> 4) & 1) + 4 * (lane & 3);
          s16x4 lo = __builtin_amdgcn_ds_read_tr16_b64_v4i16((lds_s4p)vb);
          s16x4 hi = __builtin_amdgcn_ds_read_tr16_b64_v4i16((lds_s4p)(vb + 8 * 96));
          bf16x8 vf;
          vf[0] = lo[0]; vf[1] = lo[1]; vf[2] = lo[2]; vf[3] = lo[3];
          vf[4] = hi[0]; vf[5] = hi[1]; vf[6] = hi[2]; vf[7] = hi[3];
          o[db] = __builtin_amdgcn_mfma_f32_32x32x16_bf16(vf, pf, o[db], 0, 0, 0);
        }
      }
  }
  float inv = 1.f / lsum;
#pragma unroll
  for (int db = 0; db < 2; db++)
#pragma unroll
    for (int g = 0; g < 4; g++) {
      int dv = db * 32 + 8 * g + 4 * hh;
      uint2 ov;
      ov.x = pack2(o[db][4 * g] * inv, o[db][4 * g + 1] * inv);
      ov.y = pack2(o[db][4 * g + 2] * inv, o[db][4 * g + 3] * inv);
      *(uint2*)(O + (size_t)qi * ldo + dv) = ov;
    }
}

__device__ void attn_dispatch(PRef p, int l, int it, AttnSm* sm) {
  const int nA = 2048, nB = (l == 0) ? 256 : 0, nC = 2048;
  if (it < nA + nB) {
    int b, h, row0, ktiles;
    if (it < nA) { b = it >> 7; h = (it >> 4) & 7; int qt = it & 15; row0 = b * TPB + 256 + qt * 128; ktiles = 36; }
    else { int j = it - nA; b = j >> 4; h = (j >> 1) & 7; int qt = j & 1; row0 = b * TPB + qt * 128; ktiles = 4; }
    attn_item<96>(p.Q + (size_t)row0 * 768 + h * 96, 768, p.KV + h * 128, 1024, p.KR + h * 32, 256, p.KV + h * 128 + 64,
                  1024, b * TPB, ktiles, 0, 0, row0, false, 0.10206207261596575f, false, 0.f,
                  p.ZB + (size_t)row0 * 512 + h * 64, 512, sm);
  } else {
    int j = it - nA - nB;
    float sink;
    int b, h, row0, s0row, s0t, s1row, s1t;
    bool msk;
    if (j < nC) {
      b = j >> 7; h = (j >> 4) & 7; int qt = j & 15;
      row0 = b * TPB + 256 + qt * 128;
      int lo = (qt - 1) * 128; if (lo < 0) lo = 0;
      int hi = (qt + 2) * 128; if (hi > 2048) hi = 2048;
      s0row = b * TPB + 256 + lo; s0t = (hi - lo) / 64; s1row = b * TPB; s1t = 4; msk = true;
    } else {
      int jj = j - nC;
      b = jj >> 4; h = (jj >> 1) & 7; int qt = jj & 1;
      row0 = b * TPB + qt * 128; s0row = b * TPB; s0t = 4; s1row = 0; s1t = 0; msk = false;
    }
    sink = p.c_sink[l * 8 + h];
    int kvh = h >> 2;
    attn_item<64>(p.ZC + (size_t)row0 * 768 + h * 64, 768, p.ZC + 512 + kvh * 64, 768, nullptr, 0, p.ZC + 640 + kvh * 64, 768,
                  s0row, s0t, s1row, s1t, row0, msk, 0.125f, true, sink, p.ZC + (size_t)row0 * 768 + h * 64, 768, sm);
  }
}

struct ScanRec {
  float w[64], kk[64], kka[64], kd[64], r[64], v[64];
};
struct ScanSm {
  ScanRec rec[2][16];
  float st[4][2][64];
  float xch[2 * 2 * 64 * 4];
};
DEV int scan_row(int b, int d, int s) {
  bool isctx = s < 256;
  int pos = isctx ? (d ? 255 - s : s) : (d ? 2047 - (s - 256) : s - 256);
  return b * TPB + (isctx ? 0 : 256) + pos;
}
struct PrepConst {
  int cols[5];
  float mup[5], mun[5];
  float w0v, a0v, kkc, kac, rkc;
  uint32_t wu[32], au[32];
};
struct PrepRaw {
  bf16 zc[5], zp[5], zn[5];
  float fp, fn;
  int row;
};
DEV void prep_load(PRef p, const PrepConst& pc, int b, int d, int s, PrepRaw& rw) {
  bool isctx = s < 256;
  int pos = isctx ? (d ? 255 - s : s) : (d ? 2047 - (s - 256) : s - 256);
  int seglen = isctx ? 256 : 2048;
  int row = b * TPB + (isctx ? 0 : 256) + pos;
  rw.row = row;
  bool hp = pos > 0, hn = pos < seglen - 1;
  const bf16* z = p.ZA + (size_t)row * 1792;
  const bf16* zpp = hp ? z - 1792 : z;
  const bf16* znp = hn ? z + 1792 : z;
  rw.fp = hp ? 1.f : 0.f;
  rw.fn = hn ? 1.f : 0.f;
#pragma unroll
  for (int i = 0; i < 5; i++) {
    int col = pc.cols[i];
    rw.zc[i] = z[col];
    rw.zp[i] = zpp[col];
    rw.zn[i] = znp[col];
  }
}
typedef __bf16 bf16v2 __attribute__((ext_vector_type(2)));
DEV float dot2bf(uint32_t a, uint32_t b, float c) {
  return __builtin_amdgcn_fdot2_f32_bf16(*(bf16v2*)&a, *(bf16v2*)&b, c, false);
}
DEV void prep_compute(PRef p, const PrepConst& pc, const PrepRaw& rw, int h, int d, ScanRec* rc, float* stw, int lane) {
  float vals[5];
#pragma unroll
  for (int i = 0; i < 5; i++) {
    float zc = bf2f(rw.zc[i]), zp = rw.fp * bf2f(rw.zp[i]), zn = rw.fn * bf2f(rw.zn[i]);
    vals[i] = zc + pc.mup[i] * (zp - zc) + pc.mun[i] * (zn - zc);
  }
  float rv = vals[0], kv = vals[1], vv = vals[2];
  float th = 1.f - __fdividef(2.f, 1.f + __expf(2.f * vals[3]));
  bf16* stb = (bf16*)stw;
  wbar();
  stb[lane] = f2bf(th);
  stb[64 + lane] = f2bf(vals[4]);
  wbar();
  float wl0 = pc.w0v, wl1 = 0.f, al0 = pc.a0v, al1 = 0.f;
  const uint4* st4 = (const uint4*)stw;
#pragma unroll
  for (int g = 0; g < 8; g++) {
    uint4 t = st4[g];
    uint4 u = st4[8 + g];
    wl0 = dot2bf(t.x, pc.wu[4 * g], wl0);
    wl1 = dot2bf(t.y, pc.wu[4 * g + 1], wl1);
    wl0 = dot2bf(t.z, pc.wu[4 * g + 2], wl0);
    wl1 = dot2bf(t.w, pc.wu[4 * g + 3], wl1);
    al0 = dot2bf(u.x, pc.au[4 * g], al0);
    al1 = dot2bf(u.y, pc.au[4 * g + 1], al1);
    al0 = dot2bf(u.z, pc.au[4 * g + 2], al0);
    al1 = dot2bf(u.w, pc.au[4 * g + 3], al1);
  }
  float wl = wl0 + wl1, al = al0 + al1;
  float zz = -wl;
  float sp = zz > 20.f ? zz : __logf(1.f + __expf(zz));
  float wlog = -sp - 0.5f;
  float dec = __expf(-__expf(wlog));
  float a = __fdividef(1.f, 1.f + __expf(-al));
  float kkv = kv * pc.kkc;
  float ssk = wave_sum(kkv * kkv);
  kkv *= rsqrtf(fmaxf(ssk, 1e-24f));
  float kdv = kv * (1.f + (a - 1.f) * pc.kac);
  float bon = wave_sum(rv * kdv * pc.rkc);
  rc->w[lane] = dec;
  rc->kk[lane] = kkv;
  rc->kka[lane] = kkv * a;
  rc->kd[lane] = kdv;
  rc->r[lane] = rv;
  rc->v[lane] = vv;
  if (lane == 0) p.SB[(size_t)rw.row * 16 + d * 8 + h] = bon;
}
DEV void prep_compute2(PRef p, const PrepConst& pc, const PrepRaw& rwA, const PrepRaw& rwB, int h, int d,
                       ScanRec* rcA, ScanRec* rcB, float* stw, int lane, float& Dprev) {
  float valsA[5], valsB[5];
#pragma unroll
  for (int i = 0; i < 5; i++) {
    float zc = bf2f(rwA.zc[i]), zp = rwA.fp * bf2f(rwA.zp[i]), zn = rwA.fn * bf2f(rwA.zn[i]);
    valsA[i] = zc + pc.mup[i] * (zp - zc) + pc.mun[i] * (zn - zc);
    float zc2 = bf2f(rwB.zc[i]), zp2 = rwB.fp * bf2f(rwB.zp[i]), zn2 = rwB.fn * bf2f(rwB.zn[i]);
    valsB[i] = zc2 + pc.mup[i] * (zp2 - zc2) + pc.mun[i] * (zn2 - zc2);
  }
  float thA = 1.f - __fdividef(2.f, 1.f + __expf(2.f * valsA[3]));
  float thB = 1.f - __fdividef(2.f, 1.f + __expf(2.f * valsB[3]));
  bf16* stb = (bf16*)stw;
  wbar();
  stb[lane] = f2bf(thA);
  stb[64 + lane] = f2bf(valsA[4]);
  stb[128 + lane] = f2bf(thB);
  stb[192 + lane] = f2bf(valsB[4]);
  wbar();
  float wA0 = pc.w0v, wA1 = 0.f, aA0 = pc.a0v, aA1 = 0.f;
  float wB0 = pc.w0v, wB1 = 0.f, aB0 = pc.a0v, aB1 = 0.f;
  const uint4* st4 = (const uint4*)stw;
#pragma unroll
  for (int g = 0; g < 8; g++) {
    uint4 tA = st4[g], uA = st4[8 + g], tB = st4[16 + g], uB = st4[24 + g];
    uint32_t w0 = pc.wu[4 * g], w1 = pc.wu[4 * g + 1], w2 = pc.wu[4 * g + 2], w3 = pc.wu[4 * g + 3];
    uint32_t u0 = pc.au[4 * g], u1 = pc.au[4 * g + 1], u2 = pc.au[4 * g + 2], u3 = pc.au[4 * g + 3];
    wA0 = dot2bf(tA.x, w0, wA0); wB0 = dot2bf(tB.x, w0, wB0);
    wA1 = dot2bf(tA.y, w1, wA1); wB1 = dot2bf(tB.y, w1, wB1);
    wA0 = dot2bf(tA.z, w2, wA0); wB0 = dot2bf(tB.z, w2, wB0);
    wA1 = dot2bf(tA.w, w3, wA1); wB1 = dot2bf(tB.w, w3, wB1);
    aA0 = dot2bf(uA.x, u0, aA0); aB0 = dot2bf(uB.x, u0, aB0);
    aA1 = dot2bf(uA.y, u1, aA1); aB1 = dot2bf(uB.y, u1, aB1);
    aA0 = dot2bf(uA.z, u2, aA0); aB0 = dot2bf(uB.z, u2, aB0);
    aA1 = dot2bf(uA.w, u3, aA1); aB1 = dot2bf(uB.w, u3, aB1);
  }
  float zzA = -(wA0 + wA1), zzB = -(wB0 + wB1);
  float spA = zzA > 20.f ? zzA : __logf(1.f + __expf(zzA));
  float spB = zzB > 20.f ? zzB : __logf(1.f + __expf(zzB));
  float decA = __expf(-__expf(-spA - 0.5f)), decB = __expf(-__expf(-spB - 0.5f));
  float aA = __fdividef(1.f, 1.f + __expf(-(aA0 + aA1))), aB = __fdividef(1.f, 1.f + __expf(-(aB0 + aB1)));
  float kkA = valsA[1] * pc.kkc, kkB = valsB[1] * pc.kkc;
  float ssA = wave_sum(kkA * kkA), ssB = wave_sum(kkB * kkB);
  kkA *= rsqrtf(fmaxf(ssA, 1e-24f));
  kkB *= rsqrtf(fmaxf(ssB, 1e-24f));
  float kdA = valsA[1] * (1.f + (aA - 1.f) * pc.kac), kdB = valsB[1] * (1.f + (aB - 1.f) * pc.kac);
  float bonA = wave_sum(valsA[0] * kdA * pc.rkc), bonB = wave_sum(valsB[0] * kdB * pc.rkc);
  float DA = Dprev * decA, DB = DA * decB;
  float iDA = __fdividef(1.f, DA), iDB = __fdividef(1.f, DB);
  rcA->w[lane] = DA; rcB->w[lane] = DB;
  rcA->kk[lane] = kkA * Dprev; rcB->kk[lane] = kkB * DA;
  rcA->kka[lane] = kkA * aA * iDA; rcB->kka[lane] = kkB * aB * iDB;
  rcA->kd[lane] = kdA * iDA; rcB->kd[lane] = kdB * iDB;
  rcA->r[lane] = valsA[0] * DA; rcB->r[lane] = valsB[0] * DB;
  rcA->v[lane] = valsA[2]; rcB->v[lane] = valsB[2];
  Dprev = DB;
  if (lane == 0) {
    p.SB[(size_t)rwA.row * 16 + d * 8 + h] = bonA;
    p.SB[(size_t)rwB.row * 16 + d * 8 + h] = bonB;
  }
}
#define CBAR asm volatile("" ::: "memory")
#define PIN2(x, y) asm volatile("" : "+v"(x), "+v"(y) : : "memory")
template <int G>
DEV void ldg(f32x4v (&bb)[8], const ScanRec* rc, int kh) {
  if (G < 2) {
#pragma unroll
    for (int q = 0; q < 4; q++) bb[q] = *(const f32x4v*)&rc->kk[32 * kh + 16 * G + 4 * q];
  } else {
    constexpr int o = G - 2;
#pragma unroll
    for (int jj = 0; jj < 2; jj++) {
      int k0 = 32 * kh + 4 * (2 * o + jj);
      bb[4 * jj + 0] = *(const f32x4v*)&rc->w[k0];
      bb[4 * jj + 1] = *(const f32x4v*)&rc->kka[k0];
      bb[4 * jj + 2] = *(const f32x4v*)&rc->kd[k0];
      bb[4 * jj + 3] = *(const f32x4v*)&rc->r[k0];
    }
  }
}
template <int G>
DEV void cmpg(const f32x4v (&bb)[8], float2v (&S)[16], float2v& a0, float2v& a1, float nsa, float vv, float2v& y0, float2v& y1) {
  if (G < 2) {
#pragma unroll
    for (int q = 0; q < 4; q++) {
      int j = 4 * G + q;
      a0 += S[2 * j] * float2v{bb[q].x, bb[q].y};
      a1 += S[2 * j + 1] * float2v{bb[q].z, bb[q].w};
    }
  } else {
    constexpr int o = G - 2;
#pragma unroll
    for (int jj = 0; jj < 2; jj++) {
      int j = 2 * o + jj;
      f32x4v w4 = bb[4 * jj], q4 = bb[4 * jj + 1], d4 = bb[4 * jj + 2], r4 = bb[4 * jj + 3];
      float2v s0 = S[2 * j] * float2v{w4.x, w4.y} + nsa * float2v{q4.x, q4.y} + vv * float2v{d4.x, d4.y};
      float2v s1 = S[2 * j + 1] * float2v{w4.z, w4.w} + nsa * float2v{q4.z, q4.w} + vv * float2v{d4.z, d4.w};
      S[2 * j] = s0;
      S[2 * j + 1] = s1;
      y0 += s0 * float2v{r4.x, r4.y};
      y1 += s1 * float2v{r4.z, r4.w};
    }
  }
}
DEV void scan_publish(f32x4v* mine, float sa_p, float y_p, int tag) {
  f32x4v v;
  v.x = sa_p; v.y = y_p; v.z = __int_as_float(tag); v.w = 0.f;
  *mine = v;
  asm volatile("" ::: "memory");
}
DEV void scan_collect(const f32x4v* theirs, int tag, float& sa_o, float& y_o) {
  f32x4v o;
  while (true) {
    o = *(const volatile __attribute__((address_space(3))) f32x4v*)theirs;
    if (__all(__float_as_int(o.z) == tag)) break;
  }
  asm volatile("" ::: "memory");
  sa_o = o.x;
  y_o = o.y;
}
#define PIN4(a, b, c, d) asm volatile("" : "+v"(a), "+v"(b), "+v"(c), "+v"(d) : : "memory")
#define SCAN_G(G, BUFC, BUFL)                                                  \
  ldg<((G) + 2) % 6>(BUFL, rc, kh);                                            \
  CBAR;                                                                        \
  cmpg<G>(BUFC, S, a0, a1, nsa, vv, y0, y1);                                   \
  PIN2(a0, a1);
#define SCAN_PRE(O, BUFC, BUFL, LDSTMT, KQ)                                    \
  LDSTMT;                                                                      \
  CBAR;                                                                        \
  _Pragma("unroll") for (int jj = 0; jj < 2; jj++) {                           \
    int j = 2 * (O) + jj;                                                      \
    f32x4v w4 = BUFC[4 * jj], d4 = BUFC[4 * jj + 2];                           \
    S[2 * j] = S[2 * j] * float2v{w4.x, w4.y} + vv * float2v{d4.x, d4.y};      \
    S[2 * j + 1] = S[2 * j + 1] * float2v{w4.z, w4.w} + vv * float2v{d4.z, d4.w}; \
    KQ[2 * jj] = BUFC[4 * jj + 1];                                             \
    KQ[2 * jj + 1] = BUFC[4 * jj + 3];                                         \
  }                                                                            \
  PIN4(S[4 * (O)], S[4 * (O) + 1], S[4 * (O) + 2], S[4 * (O) + 3]);
#define SCAN_POST(O, KQ)                                                       \
  _Pragma("unroll") for (int jj = 0; jj < 2; jj++) {                           \
    int j = 2 * (O) + jj;                                                      \
    f32x4v q4 = KQ[2 * jj], r4 = KQ[2 * jj + 1];                               \
    float2v s0 = S[2 * j] + nsa * float2v{q4.x, q4.y};                         \
    float2v s1 = S[2 * j + 1] + nsa * float2v{q4.z, q4.w};                     \
    S[2 * j] = s0;                                                             \
    S[2 * j + 1] = s1;                                                         \
    y0 += s0 * float2v{r4.x, r4.y};                                            \
    y1 += s1 * float2v{r4.z, r4.w};                                            \
  }
__device__ void scan_chain(PRef p, int l, int chain, ScanSm* sm) {
  int b = chain >> 4, h = (chain >> 1) & 7, d = chain & 1;
  int tid = tid_(), wave = tid >> 6, lane = tid & 63;
  f32x4v* xch = (f32x4v*)sm->xch;
  __syncthreads();
  if (wave < 2) {
    xch[(0 * 2 + wave) * 64 + lane] = f32x4v{0.f, 0.f, 0.f, 0.f};
    xch[(1 * 2 + wave) * 64 + lane] = f32x4v{0.f, 0.f, 0.f, 0.f};
  }
  __syncthreads();
  if (wave < 2) __builtin_amdgcn_s_setprio(3); else __builtin_amdgcn_s_setprio(3);
  if (wave < 2) {
    const int kh = wave;
    float S[32];
#pragma unroll
    for (int j = 0; j < 32; j++) S[j] = 0.f;
    bf16* Y = p.HY + (size_t)d * NROWS * 512 + h * 64 + lane;
    float yprev = 0.f;
    int rowcur = b * TPB + (d ? 255 : 0), rowprev = rowcur;
    const int rstep = d ? -1 : 1;
    const int ko = 32 * kh + (lane & 15);
    float Akk0, Akk1, Aw0, Aw1, Aq0, Aq1, Ad0, Ad1, Ar0, Ar1, Av;
    float Bkk0, Bkk1, Bw0, Bw1, Bq0, Bq1, Bd0, Bd1, Br0, Br1, Bv;
#define LDSET(P, RC)                                                           \
  P##kk0 = (RC)->kk[ko]; P##kk1 = (RC)->kk[ko + 16];                           \
  P##w0 = (RC)->w[ko]; P##w1 = (RC)->w[ko + 16];                               \
  P##q0 = (RC)->kka[ko]; P##q1 = (RC)->kka[ko + 16];                           \
  P##d0 = (RC)->kd[ko]; P##d1 = (RC)->kd[ko + 16];                             \
  P##r0 = (RC)->r[ko]; P##r1 = (RC)->r[ko + 16];                               \
  P##v = (RC)->v[lane];
#define DPPF(J, ACC, BC, SRC) asm("v_fmac_f32_dpp %0, %1, %2 row_newbcast:" #J " row_mask:0xf bank_mask:0xf" : "+v"(ACC) : "v"(BC), "v"(SRC));
#define DPPM(J, DST, BC) asm("v_mul_f32_dpp %0, %1, %0 row_newbcast:" #J " row_mask:0xf bank_mask:0xf" : "+v"(DST) : "v"(BC));
#define REP16(M, ...) M(0, __VA_ARGS__) M(1, __VA_ARGS__) M(2, __VA_ARGS__) M(3, __VA_ARGS__) M(4, __VA_ARGS__) M(5, __VA_ARGS__) \
  M(6, __VA_ARGS__) M(7, __VA_ARGS__) M(8, __VA_ARGS__) M(9, __VA_ARGS__) M(10, __VA_ARGS__) M(11, __VA_ARGS__) M(12, __VA_ARGS__) \
  M(13, __VA_ARGS__) M(14, __VA_ARGS__) M(15, __VA_ARGS__)
#define OP_SA(J, G, BC) DPPF(J, sacc[2 * G + (J & 1)], BC, S[16 * G + J])
#define OP_PRE1(J, G, BCW) DPPM(J, S[16 * G + J], BCW)
#define OP_PRE2(J, G, BCD) DPPF(J, S[16 * G + J], BCD, vv)
#define OP_POST(J, G, BCQ, BCR) DPPF(J, S[16 * G + J], BCQ, nsa) DPPF(J, yacc[2 * G + (J & 1)], BCR, S[16 * G + J])
#define SCAN_STEP(P, SIDX)                                                     \
  {                                                                            \
    const int s_ = (SIDX);                                                     \
    const int par_ = s_ & 1;                                                   \
    float sacc[4] = {0.f, 0.f, 0.f, 0.f};                                      \
    REP16(OP_SA, 0, P##kk0)                                                    \
    REP16(OP_SA, 1, P##kk1)                                                    \
    float sa_p = (sacc[0] + sacc[1]) + (sacc[2] + sacc[3]);                    \
    scan_publish(&xch[(par_ * 2 + kh) * 64 + lane], sa_p, yprev, s_ + 1);      \
    float vv = P##v;                                                           \
    REP16(OP_PRE2, 0, P##d0)                                                   \
      \
    f32x4v early_ = *(const volatile __attribute__((address_space(3))) f32x4v*)&xch[(par_ * 2 + (1 - kh)) * 64 + lane]; \
    REP16(OP_PRE2, 1, P##d1)                                                   \
    float sa_o, y_o;                                                           \
    if (__all(__float_as_int(early_.z) == s_ + 1)) { sa_o = early_.x; y_o = early_.y; }                 \
    else scan_collect(&xch[(par_ * 2 + (1 - kh)) * 64 + lane], s_ + 1, sa_o, y_o);                      \
    float nsa = -(sa_p + sa_o);                                                \
    if (kh == 0 && s_ > 0) Y[(size_t)rowprev * 512] = f2bf(yprev + y_o);                  \
    rowprev = rowcur;                                                          \
    rowcur = (s_ == 255) ? (b * TPB + 256 + (d ? 2047 : 0)) : rowcur + rstep;  \
    float yacc[4] = {0.f, 0.f, 0.f, 0.f};                                      \
    REP16(OP_POST, 0, P##q0, P##r0)                                            \
    REP16(OP_POST, 1, P##q1, P##r1)                                            \
    yprev = (yacc[0] + yacc[1]) + (yacc[2] + yacc[3]);                         \
    if ((s_ & 7) == 7) {     \
      REP16(OP_PRE1, 0, P##w0)                                                 \
      REP16(OP_PRE1, 1, P##w1)                                                 \
    }                                                                          \
  }
#pragma unroll 1
    for (int c = 0; c < 144; c++) {
      __syncthreads();
      const ScanRec* rc0 = &sm->rec[c & 1][0];
      LDSET(A, rc0)
#pragma unroll 1
      for (int i2 = 0; i2 < 8; i2++) {
        const ScanRec* rcA = rc0 + 2 * i2;
        const ScanRec* rcC = (i2 < 7) ? rcA + 2 : rcA + 1;
        LDSET(B, rcA + 1)
        SCAN_STEP(A, c * 16 + 2 * i2)
        LDSET(A, rcC)
        SCAN_STEP(B, c * 16 + 2 * i2 + 1)
      }
    }
    {
      float sa_o, y_o;
      scan_publish(&xch[(0 * 2 + kh) * 64 + lane], 0.f, yprev, 2305);
      scan_collect(&xch[(0 * 2 + (1 - kh)) * 64 + lane], 2305, sa_o, y_o);
      if (kh == 0) Y[(size_t)scan_row(b, d, 2303) * 512] = f2bf(yprev + y_o);
    }
#undef LDSET
#undef SCAN_STEP
  } else {
    PrepConst pc;
    int hc = h * 64 + lane;
    pc.cols[0] = hc; pc.cols[1] = 512 + hc; pc.cols[2] = 1024 + hc; pc.cols[3] = 1536 + d * 64 + lane; pc.cols[4] = 1664 + d * 64 + lane;
#pragma unroll
    for (int i = 0; i < 5; i++) { pc.mup[i] = p.a_mu_prev[l * 1792 + pc.cols[i]]; pc.mun[i] = p.a_mu_next[l * 1792 + pc.cols[i]]; }
    pc.w0v = p.a_w0[l * 1024 + d * 512 + hc];
    pc.a0v = p.a_a0[l * 1024 + d * 512 + hc];
    pc.kkc = p.a_k_k[l * 512 + hc];
    pc.kac = p.a_k_a[l * 512 + hc];
    pc.rkc = p.a_r_k[l * 512 + hc];
    {
      const float* wu = p.a_w_up + ((size_t)(l * 2 + d) * 64) * 512 + hc;
      const float* au = p.a_a_up + ((size_t)(l * 2 + d) * 64) * 512 + hc;
#pragma unroll
      for (int r = 0; r < 32; r++) {
        pc.wu[r] = pack2(wu[(2 * r) * 512], wu[(2 * r + 1) * 512]);
        pc.au[r] = pack2(au[(2 * r) * 512], au[(2 * r + 1) * 512]);
      }
    }
    float* stw = &sm->st[wave][0][0];
    const int base = (wave - 2) * 8;
    int i = base, c = 0;
    float Dprev = 1.f;
    PrepRaw rwA, rwB, rnA, rnB;
    prep_load(p, pc, b, d, i, rwA);
    prep_load(p, pc, b, d, i + 1, rwB);
#pragma unroll 1
    while (c < 144) {
      int i2 = i + 2, c2 = c;
      if (i2 >= base + 8) { i2 = base; c2 = c + 1; }
      if (c2 < 144) {
        prep_load(p, pc, b, d, c2 * 16 + i2, rnA);
        prep_load(p, pc, b, d, c2 * 16 + i2 + 1, rnB);
      }
      if (i == base) Dprev = 1.f;
      prep_compute2(p, pc, rwA, rwB, h, d, &sm->rec[c & 1][i], &sm->rec[c & 1][i + 1], stw, lane, Dprev);
      if (c2 != c) __syncthreads();
      rwA = rnA;
      rwB = rnB;
      i = i2;
      c = c2;
    }
  }
  __builtin_amdgcn_s_setprio(0);
}

__device__ void phase_readout(PRef p, int l) {
  int tid = tid_();
  int wave = tid >> 6, lane = tid & 63;
  int gw = bid_() * 4 + wave, nw = gridDim.x * 4;
  int h = lane >> 3, sub = lane & 7;
  int c0 = h * 64 + sub * 8;
  float mup[8], mun[8], gg[8], gb[8];
#pragma unroll
  for (int j = 0; j < 8; j++) {
    mup[j] = p.a_mu_prev[l * 1792 + 1024 + c0 + j];
    mun[j] = p.a_mu_next[l * 1792 + 1024 + c0 + j];
    gg[j] = p.a_gn_g[l * 512 + c0 + j];
    gb[j] = p.a_gn_b[l * 512 + c0 + j];
  }
  for (int R = gw; R < NROWS; R += nw) {
    int tp = R % TPB;
    if (l == 1 && tp < 256) continue;
    bool isctx = tp < 256;
    int pos = isctx ? tp : tp - 256;
    int seglen = isctx ? 256 : 2048;
    bool hp = pos > 0, hn = pos < seglen - 1;
    const bf16* z = p.ZA + (size_t)R * 1792 + 1024 + c0;
    bf16* y0p = p.HY + (size_t)R * 512 + c0;
    const bf16* y1p = p.HY + (size_t)NROWS * 512 + (size_t)R * 512 + c0;
    u32x4 a0 = *(const u32x4*)y0p, a1 = *(const u32x4*)y1p;
    u32x4 zc = *(const u32x4*)z;
    u32x4 zp = *(const u32x4*)(hp ? z - 1792 : z);
    u32x4 zn = *(const u32x4*)(hn ? z + 1792 : z);
    float bs = p.SB[(size_t)R * 16 + h] + p.SB[(size_t)R * 16 + 8 + h];
    float fp = hp ? 1.f : 0.f, fn = hn ? 1.f : 0.f;
    float y[8];
    float sum = 0.f;
#pragma unroll
    for (int j = 0; j < 4; j++) {
      y[2 * j] = bflo(a0[j]) + bflo(a1[j]);
      y[2 * j + 1] = bfhi(a0[j]) + bfhi(a1[j]);
      sum += y[2 * j] + y[2 * j + 1];
    }
    float mu = group8_sum(sum) * (1.f / 64.f);
    float sq = 0.f;
#pragma unroll
    for (int j = 0; j < 8; j++) { y[j] -= mu; sq += y[j] * y[j]; }
    float rs = rsqrtf(group8_sum(sq) * (1.f / 64.f) + 64e-5f);
    u32x4 ov;
#pragma unroll
    for (int j = 0; j < 4; j++) {
      float c_lo = bflo(zc[j]), c_hi = bfhi(zc[j]);
      float v_lo = c_lo + mup[2 * j] * (fp * bflo(zp[j]) - c_lo) + mun[2 * j] * (fn * bflo(zn[j]) - c_lo);
      float v_hi = c_hi + mup[2 * j + 1] * (fp * bfhi(zp[j]) - c_hi) + mun[2 * j + 1] * (fn * bfhi(zn[j]) - c_hi);
      float o_lo = y[2 * j] * rs * gg[2 * j] + gb[2 * j] + bs * v_lo;
      float o_hi = y[2 * j + 1] * rs * gg[2 * j + 1] + gb[2 * j + 1] + bs * v_hi;
      ov[j] = pack2(o_lo, o_hi);
    }
    *(u32x4*)y0p = ov;
  }
}

DEV bool skip_rt(int l, int rt) { return l == 1 && (rt % 18) < 2; }

__device__ void phase_gates(PRef p, int l, const bf16* H2, bf16* sA, bf16* sB) {
  const int xcd_ = bid_() & 7, per_ = gridDim.x >> 3;
  for (int t = bid_() >> 3; t < 36 * 12; t += per_) {
    int rt = xcd_ + 8 * (t / 12), ct = t % 12;
    if (skip_rt(l, rt)) continue;
    f32x16 acc[2][2];
    zero_acc<2>(acc);
    gemm_tile<2>(acc, H2 + (size_t)rt * 128 * 1024, 1024, p.WT2 + (size_t)ct * 128 * 1024, 1024, 1024, sA, sB);
    int n = ct >> 2, c0 = (ct & 3) * 128;
    bf16* dst = n == 0 ? p.HY : (n == 1 ? p.ZB : p.ZC);
    int ld = n == 2 ? 768 : 512;
    stage_tile<2>(acc, sA);
    TILE_CHUNKS(2, sA, {
      u32x4* pp = (u32x4*)(dst + (size_t)(rt * 128 + trow) * ld + c0 + tcol);
      u32x4 yv = *pp;
      u32x4 ov;
      _Pragma("unroll") for (int j = 0; j < 4; j++) {
        float g0 = __uint_as_float(cv[j] << 16), g1 = __uint_as_float(cv[j] & 0xffff0000u);
        g0 = g0 / (1.f + __expf(-g0));
        g1 = g1 / (1.f + __expf(-g1));
        float y0 = __uint_as_float(yv[j] << 16), y1 = __uint_as_float(yv[j] & 0xffff0000u);
        ov[j] = pack2(y0 * g0, y1 * g1);
      }
      *pp = ov;
    })
  }
}

__device__ void phase_merge(PRef p, int l, const bf16* H2, bf16* M, bf16* sA, bf16* sB) {
  const int xcd_ = bid_() & 7, per_ = gridDim.x >> 3;
  for (int t = bid_() >> 3; t < 36 * 8; t += per_) {
    int rt = xcd_ + 8 * (t / 8), ct = t % 8;
    if (skip_rt(l, rt)) continue;
#pragma unroll 1
    for (int n = 0; n < 3; n++) {
      const bf16* U = n == 0 ? p.HY : (n == 1 ? p.ZB : p.ZC);
      int ldu = n == 2 ? 768 : 512;
      uint32_t gp[2][2][8];
      {
        f32x16 a2[2][2];
        zero_acc<2>(a2);
        gemm_tile<2>(a2, H2 + (size_t)rt * 128 * 1024, 1024, p.WT3 + ((size_t)n * 1024 + ct * 128) * 1024, 1024, 1024, sA, sB);
#pragma unroll
        for (int a = 0; a < 2; a++)
#pragma unroll
          for (int bb = 0; bb < 2; bb++)
#pragma unroll
            for (int r = 0; r < 8; r++) {
              float g0 = __fdividef(1.f, 1.f + __expf(-a2[a][bb][2 * r]));
              float g1 = __fdividef(1.f, 1.f + __expf(-a2[a][bb][2 * r + 1]));
              gp[a][bb][r] = pack2(g0, g1);
            }
      }
      f32x16 a1[2][2];
      zero_acc<2>(a1);
      gemm_tile<2, false>(a1, U + (size_t)rt * 128 * ldu, ldu, p.WBO + ((size_t)n * 1024 + ct * 128) * 512, 512, 512, sA, sB);
#pragma unroll
      for (int a = 0; a < 2; a++)
#pragma unroll
        for (int bb = 0; bb < 2; bb++)
#pragma unroll
          for (int r = 0; r < 8; r++) {
            a1[a][bb][2 * r] *= bflo(gp[a][bb][r]);
            a1[a][bb][2 * r + 1] *= bfhi(gp[a][bb][r]);
          }
      stage_tile<2>(a1, sA);
      TILE_CHUNKS(2, sA, {
        u32x4* mp = (u32x4*)(M + (size_t)(rt * 128 + trow) * 1024 + ct * 128 + tcol);
        u32x4 ov = cv;
        if (n != 0) {
          u32x4 pv = *mp;
          _Pragma("unroll") for (int j = 0; j < 4; j++) ov[j] = pack2(bflo(pv[j]) + bflo(cv[j]), bfhi(pv[j]) + bfhi(cv[j]));
        }
        *mp = ov;
      })
    }
  }
}

__device__ void phase_out(PRef p, int l, const bf16* M, const float* xl, const float* xc, bf16* sA, bf16* sB) {
  const int xcd_ = bid_() & 7, per_ = gridDim.x >> 3;
  for (int t = bid_() >> 3; t < 36 * 8; t += per_) {
    int rt = xcd_ + 8 * (t / 8), ct = t % 8;
    if (skip_rt(l, rt)) continue;
    f32x16 acc[2][2];
    zero_acc<2>(acc);
    gemm_tile<2>(acc, M + (size_t)rt * 128 * 1024, 1024, p.WOUT + (size_t)ct * 128 * 1024, 1024, 1024, sA, sB);
    int b = rt / 18;
    bool isctx = (rt % 18) < 2;
    const float* gate = p.MOD + ((size_t)l * 17 + (isctx ? 16 : b)) * 3072 + 2048;
    stage_tile<2>(acc, sA);
    TILE_CHUNKS(2, sA, {
      int R = rt * 128 + trow;
      int col = ct * 128 + tcol;
      int tp = R % TPB;
      const float* xin;
      float* dstp;
      if (isctx) {
        xin = xc + ((size_t)b * 256 + tp) * 1024 + col;
        dstp = p.XC + ((size_t)b * 256 + tp) * 1024 + col;
      } else {
        xin = xl + ((size_t)b * 2048 + (tp - 256)) * 1024 + col;
        dstp = p.out + ((size_t)b * 2048 + (tp - 256)) * 1024 + col;
      }
      f32x4v x0 = *(const f32x4v*)xin, x1 = *(const f32x4v*)(xin + 4);
      f32x4v g0 = *(const f32x4v*)(gate + col), g1 = *(const f32x4v*)(gate + col + 4);
      f32x4v o0, o1;
      o0.x = x0.x + g0.x * __uint_as_float(cv[0] << 16);
      o0.y = x0.y + g0.y * __uint_as_float(cv[0] & 0xffff0000u);
      o0.z = x0.z + g0.z * __uint_as_float(cv[1] << 16);
      o0.w = x0.w + g0.w * __uint_as_float(cv[1] & 0xffff0000u);
      o1.x = x1.x + g1.x * __uint_as_float(cv[2] << 16);
      o1.y = x1.y + g1.y * __uint_as_float(cv[2] & 0xffff0000u);
      o1.z = x1.z + g1.z * __uint_as_float(cv[3] << 16);
      o1.w = x1.w + g1.w * __uint_as_float(cv[3] & 0xffff0000u);
      *(f32x4v*)dstp = o0;
      *(f32x4v*)(dstp + 4) = o1;
    })
  }
}

#define GB_TOP 0
#define GB_CEN(j) (64 + 32 * (j))
#define GB_CNT(j) (640 + 32 * (j))
#define GB_GEN(j) (1216 + 32 * (j))
DEV unsigned int gb_xcc() { return (unsigned int)__builtin_amdgcn_s_getreg((3 << 11) | 20) & 0xFu; }
DEV unsigned int gb_ld(unsigned int* q) { return __hip_atomic_load(q, __ATOMIC_RELAXED, __HIP_MEMORY_SCOPE_AGENT); }
DEV unsigned int gb_add(unsigned int* q) { return __hip_atomic_fetch_add(q, 1u, __ATOMIC_RELAXED, __HIP_MEMORY_SCOPE_AGENT); }
DEV void grid_barrier(unsigned int* bar, const unsigned int* sb  ) {
  __syncthreads();
  if (threadIdx.x == 0) {
    const unsigned int x = gb_xcc();
    const unsigned int nloc = sb[0], nx = sb[1];
    const unsigned int gen = gb_ld(bar + GB_GEN(x));
    const unsigned int prev = gb_add(bar + GB_CNT(x));
    if (prev == nloc - 1) {
      __hip_atomic_store(bar + GB_CNT(x), 0u, __ATOMIC_RELAXED, __HIP_MEMORY_SCOPE_AGENT);
      __builtin_amdgcn_fence(__ATOMIC_RELEASE, "agent");
      asm volatile("s_waitcnt vmcnt(0)" ::: "memory");
      const unsigned int prevt = gb_add(bar + GB_TOP);
      if (prevt == nx - 1) {
        __hip_atomic_store(bar + GB_TOP, 0u, __ATOMIC_RELAXED, __HIP_MEMORY_SCOPE_AGENT);
        for (unsigned int y = 0; y < 16; y++)
          if (gb_ld(bar + GB_CEN(y)) != 0u) (void)gb_add(bar + GB_GEN(y));
      }
    }
    while (gb_ld(bar + GB_GEN(x)) == gen) __builtin_amdgcn_s_sleep(1);
    __builtin_amdgcn_fence(__ATOMIC_ACQUIRE, "agent");
    asm volatile("s_waitcnt vmcnt(0)" ::: "memory");
  }
  __syncthreads();
}

constexpr int NSCAN = 256;
__device__ void phase_p3_mixers(PRef p, int l, unsigned char* smem, int* s_item, bf16* sA, bf16* sB, unsigned int* bar,
                                const unsigned int* sb) {
  const bool split = gridDim.x >= 2 * NSCAN;
  const bool scan_first = split && bid_() < NSCAN;
  unsigned int* flag = p.counters + 16 + l;
  if (!scan_first) {
    const int vb = split ? bid_() - NSCAN : bid_();
    const int vg = split ? (int)gridDim.x - NSCAN : (int)gridDim.x;
    unsigned int* bx = split ? bar + 2048 : bar;
    const unsigned int* sx = split ? sb + 2 : sb;
    phase_p3a(p, sA, sB, vb, vg);
    grid_barrier(bx, sx);
    phase_p3b(p, l, (float*)smem, vb, vg);
    grid_barrier(bx, sx);
    if (split && vb == 0 && threadIdx.x == 0) __hip_atomic_store(flag, 1u, __ATOMIC_RELEASE, __HIP_MEMORY_SCOPE_AGENT);
  }
  if (scan_first || !split) {
    const int cstep = split ? NSCAN : (int)gridDim.x;
    for (int chain = bid_(); chain < NSCAN; chain += cstep) scan_chain(p, l, chain, (ScanSm*)smem);
  }
  if (scan_first) {
    if (threadIdx.x == 0) {
      while (gb_ld(flag) == 0u) __builtin_amdgcn_s_sleep(2);
      __builtin_amdgcn_fence(__ATOMIC_ACQUIRE, "agent");
      asm volatile("s_waitcnt vmcnt(0)" ::: "memory");
    }
    __syncthreads();
  }
  int total = 2048 + 2048 + ((l == 0) ? 512 : 0);
  while (true) {
    __syncthreads();
    if (tid_() == 0) *s_item = (int)atomicAdd(&p.counters[l], 1u);
    __syncthreads();
    int it = *s_item;
    if (it >= total) break;
    attn_dispatch(p, l, it, (AttnSm*)smem);
  }
}

constexpr int SMEM_BYTES = 51200 + 4096;
__global__ void __launch_bounds__(256, 2) fwd_megakernel(Params p) {
  cg::grid_group grid = cg::this_grid();
  __shared__ __attribute__((aligned(16))) unsigned char smem[SMEM_BYTES];
  __shared__ int s_item;
  bf16* sA = (bf16*)smem;
  bf16* sB = (bf16*)smem + 128 * LDT;

  CParams* pk = (CParams*)__builtin_amdgcn_kernarg_segment_ptr();
  __shared__ unsigned int s_bar[4];
  if (threadIdx.x == 0) {
    (void)gb_add(pk->counters + 64 + GB_CEN(gb_xcc()));
    if (blockIdx.x >= NSCAN) (void)gb_add(pk->counters + 64 + 2048 + GB_CEN(gb_xcc()));
  }
  {
    int l0 = 0;
    asm volatile("" : "+s"(l0));
    CParams* pk0 = pk;
    asm volatile("" : "+s"(pk0));
    phase_mod(*pk0, (float*)smem);
    phase_wconv(*pk0, l0, (float*)smem);
  }
  grid.sync();
  unsigned int* bar = pk->counters + 64;
  if (threadIdx.x == 0) {
    unsigned int nloc = gb_ld(bar + GB_CEN(gb_xcc())), nx = 0;
    for (unsigned int y = 0; y < 16; y++) nx += gb_ld(bar + GB_CEN(y)) != 0u ? 1u : 0u;
    s_bar[0] = nloc;
    s_bar[1] = nx;
    unsigned int nloc2 = gb_ld(bar + 2048 + GB_CEN(gb_xcc())), nx2 = 0;
    for (unsigned int y = 0; y < 16; y++) nx2 += gb_ld(bar + 2048 + GB_CEN(y)) != 0u ? 1u : 0u;
    s_bar[2] = nloc2;
    s_bar[3] = nx2;
  }
  __syncthreads();
#pragma unroll 1
  for (int li = 0; li < 2; li++) {
    int l = li;
    asm volatile("" : "+s"(l));
    CParams* pkq = pk;
    asm volatile("" : "+s"(pkq));
    PRef q = *pkq;
    bf16* H2 = q.Q;
    bf16* M = q.ZA;
    const float* xl = l == 0 ? q.x : q.out;
    const float* xc = l == 0 ? q.ctx : q.XC;
    if (l != 0) phase_wconv(q, l, (float*)smem);
    phase_norm(q, l, xl, xc, q.HY, false);
    grid_barrier(bar, s_bar);
    phase_gemm1(q, sA, sB);
    grid_barrier(bar, s_bar);
    phase_p3_mixers(q, l, smem, &s_item, sA, sB, bar, s_bar);
    grid_barrier(bar, s_bar);
    phase_readout(q, l);
    phase_norm(q, l, xl, xc, H2, l == 1);
    grid_barrier(bar, s_bar);
    phase_gates(q, l, H2, sA, sB);
    grid_barrier(bar, s_bar);
    phase_merge(q, l, H2, M, sA, sB);
    grid_barrier(bar, s_bar);
    phase_out(q, l, M, xl, xc, sA, sB);
    grid_barrier(bar, s_bar);
  }
}

extern "C" void kernel_launch(void* const* d_in, const int* in_sizes, int n_in, void* d_out, int out_size, void* d_ws,
                              size_t ws_size, hipStream_t stream) {
  Params p;
  memset(&p, 0, sizeof(p));
  const float** pf = (const float**)&p;
  for (int i = 0; i < 30; i++) pf[i] = (const float*)d_in[i];
  p.out = (float*)d_out;
  size_t off = 0;
  auto take = [&](size_t bytes) {
    void* r = (char*)d_ws + off;
    off += (bytes + 255) & ~(size_t)255;
    return r;
  };
  p.counters = (unsigned int*)take(16384);
  p.WT1 = (bf16*)take((size_t)3072 * 1024 * 2);
  p.WT2 = (bf16*)take((size_t)1536 * 1024 * 2);
  p.WT3 = (bf16*)take((size_t)3072 * 1024 * 2);
  p.WUQ = (bf16*)take((size_t)768 * 256 * 2);
  p.WUKV = (bf16*)take((size_t)1024 * 128 * 2);
  p.WBO = (bf16*)take((size_t)3 * 1024 * 512 * 2);
  p.WOUT = (bf16*)take((size_t)1024 * 1024 * 2);
  p.MOD = (float*)take((size_t)2 * 17 * 3072 * 4);
  p.XC = (float*)take((size_t)4096 * 1024 * 4);
  p.SB = (float*)take((size_t)NROWS * 16 * 4);
  p.ROPE = (float*)take((size_t)2048 * 48 * 2 * 4);
  p.HY = (bf16*)take((size_t)NROWS * 1024 * 2);
  p.ZA = (bf16*)take((size_t)NROWS * 1792 * 2);
  p.ZB = (bf16*)take((size_t)NROWS * 512 * 2);
  p.ZC = (bf16*)take((size_t)NROWS * 768 * 2);
  p.Q = (bf16*)take((size_t)NROWS * 768 * 2);
  p.KV = (bf16*)take((size_t)NROWS * 1024 * 2);
  p.KR = (bf16*)take((size_t)NROWS * 256 * 2);
  if (off > ws_size) {
    fprintf(stderr, "workspace too small: need %zu have %zu\n", off, ws_size);
    return;
  }
  hipMemsetAsync(p.counters, 0, 16384, stream);
  static int grid_blocks = 0;
  if (!grid_blocks) {
    int dev = 0, cus = 0, per_cu = 0;
    hipGetDevice(&dev);
    hipDeviceGetAttribute(&cus, hipDeviceAttributeMultiprocessorCount, dev);
    hipOccupancyMaxActiveBlocksPerMultiprocessor(&per_cu, fwd_megakernel, 256, 0);
    if (per_cu > 2) per_cu = 2;
    grid_blocks = cus * per_cu;
  }
  void* args[] = {&p};
  hipError_t e = hipLaunchCooperativeKernel((void*)fwd_megakernel, dim3(grid_blocks), dim3(256), args, 0, stream);
  if (e != hipSuccess) fprintf(stderr, "cooperative launch failed: %s (grid %d)\n", hipGetErrorString(e), grid_blocks);
}
```
